# Optimizing an MI355X kernel written in HIP

```python
import math
import jax, jax.numpy as jnp
from jax import lax
import numpy as np

D_MODEL = 1024
BATCH = 16
SEQ = 256
DEPTH = 2
DEC_BATCH = 8
DEC_SEQ = 1024
PAST_LEN = 256

GRID_W = 64
POOL_WINDOWS = (2, 4, 8, 16)
N_POOL_GROUPS = len(POOL_WINDOWS)
POOL_WIDTH = D_MODEL // 4
POOL_GROUP = POOL_WIDTH // N_POOL_GROUPS
ATTN_WIDTH = D_MODEL // 2
N_HEADS = 4
V_DIM = ATTN_WIDTH // N_HEADS
QK_DIM = V_DIM // 2
Q_BLOCK = 128
ROPE_BASE = 10000.0
ROPE_AXIS_DIM = QK_DIM // 2
CHUNK = 128
SGU_WIDTH = D_MODEL // 4
SGU_GROUPS = 4
SGU_GROUP_DIM = SGU_WIDTH // SGU_GROUPS
QK_WIDTH = N_HEADS * 2 * QK_DIM
IN_WIDTH = POOL_WIDTH + 2 * QK_WIDTH + ATTN_WIDTH + 2 * SGU_WIDTH
MIX_WIDTH = POOL_WIDTH + ATTN_WIDTH + SGU_WIDTH
SPLITS = (POOL_WIDTH, POOL_WIDTH + QK_WIDTH, POOL_WIDTH + 2 * QK_WIDTH,
          POOL_WIDTH + 2 * QK_WIDTH + ATTN_WIDTH)
D_FF = -(-8 * D_MODEL // (3 * 256)) * 256
N_MOD = 6
EPS = 1e-6

kernel_name = "hybrid_pool_diffattn_sgu_prefix_dit_step"


def rms_norm(x, g):
    xf = x.astype(jnp.float32)
    y = xf * lax.rsqrt(jnp.mean(xf * xf, axis=-1, keepdims=True) + EPS)
    return (y * g.astype(jnp.float32)).astype(x.dtype)


def layer_norm(x, g):
    xf = x.astype(jnp.float32)
    mu = jnp.mean(xf, axis=-1, keepdims=True)
    xc = xf - mu
    y = xc * lax.rsqrt(jnp.mean(xc * xc, axis=-1, keepdims=True) + EPS)
    return (y * g.astype(jnp.float32)).astype(x.dtype)


def ada_modulation(cond, w, b):
    m = jax.nn.silu(cond) @ w + b
    return jnp.split(m[:, None, :], N_MOD, axis=-1)


def multiscale_pool(x):
    L = x.shape[1]
    xf = x.astype(jnp.float32)
    cs = jnp.concatenate([jnp.zeros_like(xf[:, :1]), jnp.cumsum(xf, axis=1)], axis=1)
    t = np.arange(L)
    outs = []
    for g, w in enumerate(POOL_WINDOWS):
        lo = np.clip(t - w // 2, 0, L)
        hi = np.clip(t + w - w // 2, 0, L)
        sl = slice(g * POOL_GROUP, (g + 1) * POOL_GROUP)
        seg = cs[..., sl]
        cnt = jnp.asarray((hi - lo).astype(np.float32))[None, :, None]
        outs.append((seg[:, hi] - seg[:, lo]) / cnt - xf[..., sl])
    return jnp.concatenate(outs, axis=-1).astype(x.dtype)


def axial_rope_tables(L):
    n_rows = L // GRID_W
    rows = np.repeat(np.arange(n_rows), GRID_W).astype(np.float32)
    cols = np.tile(np.arange(GRID_W), n_rows).astype(np.float32)
    inv = 1.0 / (ROPE_BASE ** (np.arange(0, ROPE_AXIS_DIM, 2, dtype=np.float32) / ROPE_AXIS_DIM))
    ar, ac = rows[:, None] * inv[None], cols[:, None] * inv[None]
    return (jnp.asarray(np.cos(ar)), jnp.asarray(np.sin(ar)),
            jnp.asarray(np.cos(ac)), jnp.asarray(np.sin(ac)))


def _rotate(x, cos, sin):
    n = x.shape[-1] // 2
    x1, x2 = x[..., :n], x[..., n:]
    c, s = cos[None, :, None, :], sin[None, :, None, :]
    return jnp.concatenate([x1 * c - x2 * s, x2 * c + x1 * s], axis=-1)


def apply_axial_rope(x, cos_r, sin_r, cos_c, sin_c):
    xf = x.astype(jnp.float32)
    xr = _rotate(xf[..., :ROPE_AXIS_DIM], cos_r, sin_r)
    xc = _rotate(xf[..., ROPE_AXIS_DIM:], cos_c, sin_c)
    return jnp.concatenate([xr, xc], axis=-1).astype(x.dtype)


def diff_attention(q1, q2, k1, k2, v, lam):
    B, Lq = q1.shape[:2]
    nb = Lq // Q_BLOCK
    scale = QK_DIM ** -0.5

    def to_blocks(q):
        return q.reshape(B, nb, Q_BLOCK, N_HEADS, QK_DIM).transpose(1, 0, 2, 3, 4)

    def block(args):
        a1, a2 = args
        s1 = jnp.einsum('bqhd,bkhd->bhqk', a1, k1, preferred_element_type=jnp.float32) * scale
        s2 = jnp.einsum('bqhd,bkhd->bhqk', a2, k2, preferred_element_type=jnp.float32) * scale
        p = jax.nn.softmax(s1, axis=-1) - lam * jax.nn.softmax(s2, axis=-1)
        return jnp.einsum('bhqk,bkhe->bqhe', p.astype(v.dtype), v)

    out = lax.map(block, (to_blocks(q1), to_blocks(q2)))
    return out.transpose(1, 0, 2, 3, 4).reshape(B, Lq, N_HEADS, V_DIM)


def chunk_spatial_gating(uv, g_n, w_s, b_s):
    B, L, _ = uv.shape
    u, v = jnp.split(jax.nn.gelu(uv), 2, axis=-1)
    v = layer_norm(v, g_n).reshape(B, L // CHUNK, CHUNK, SGU_GROUPS, SGU_GROUP_DIM)
    v = jnp.einsum('gpq,bnqgc->bnpgc', w_s, v) + b_s.T[None, None, :, :, None]
    return u * v.reshape(B, L, SGU_WIDTH)


def setup_inputs(seed: int = 0) -> dict:
    key = jax.random.key(seed)
    ks = jax.random.split(key, 32)
    f32 = jnp.float32
    nrm = lambda k, shape, s: (jax.random.normal(k, shape, f32) * s)
    gain = lambda k, shape: 1.0 + 0.02 * jax.random.normal(k, shape, f32)
    return {
        "x_prompt": nrm(ks[0], (BATCH, SEQ, D_MODEL), 1.0),
        "x_sample": nrm(ks[1], (DEC_BATCH, DEC_SEQ, D_MODEL), 1.0),
        "cache_k": nrm(ks[2], (DEC_BATCH, DEPTH, PAST_LEN, N_HEADS, 2 * QK_DIM), 1.0),
        "cache_v": nrm(ks[3], (DEC_BATCH, DEPTH, PAST_LEN, N_HEADS, V_DIM), 1.0),
        "c": nrm(ks[4], (DEC_BATCH, D_MODEL), 1.0),
        "c_ctx": nrm(ks[5], (D_MODEL,), 1.0),
        "norm1_g": gain(ks[6], (DEPTH, D_MODEL)),
        "w_ada": nrm(ks[7], (DEPTH, D_MODEL, N_MOD * D_MODEL), 0.5 * D_MODEL ** -0.5),
        "b_ada": nrm(ks[8], (DEPTH, N_MOD * D_MODEL), 0.02),
        "w_in": nrm(ks[9], (DEPTH, D_MODEL, IN_WIDTH), D_MODEL ** -0.5),
        "w_pool": nrm(ks[10], (DEPTH, N_POOL_GROUPS, POOL_GROUP, POOL_GROUP), POOL_GROUP ** -0.5),
        "pool_scale": gain(ks[11], (DEPTH, POOL_WIDTH)),
        "lam_q1": nrm(ks[12], (DEPTH, QK_DIM), 0.1),
        "lam_k1": nrm(ks[13], (DEPTH, QK_DIM), 0.1),
        "lam_q2": nrm(ks[14], (DEPTH, QK_DIM), 0.1),
        "lam_k2": nrm(ks[15], (DEPTH, QK_DIM), 0.1),
        "subln_g": gain(ks[16], (DEPTH, V_DIM)),
        "sgu_norm_g": gain(ks[17], (DEPTH, SGU_WIDTH)),
        "w_sgu": nrm(ks[18], (DEPTH, SGU_GROUPS, CHUNK, CHUNK), CHUNK ** -0.5),
        "b_sgu": nrm(ks[19], (DEPTH, SGU_GROUPS, CHUNK), 0.02),
        "w_out": nrm(ks[20], (DEPTH, MIX_WIDTH, D_MODEL), MIX_WIDTH ** -0.5),
        "norm2_g": gain(ks[21], (DEPTH, D_MODEL)),
        "w_ffn_in": nrm(ks[22], (DEPTH, D_MODEL, 2 * D_FF), D_MODEL ** -0.5),
        "w_ffn_out": nrm(ks[23], (DEPTH, D_FF, D_MODEL), D_FF ** -0.5),
        "final_g": gain(ks[24], (D_MODEL,)),
    }


def reference(x_prompt, x_sample, cache_k, cache_v, c, c_ctx, norm1_g, w_ada, b_ada, w_in,
              w_pool, pool_scale, lam_q1, lam_k1, lam_q2, lam_k2, subln_g, sgu_norm_g,
              w_sgu, b_sgu, w_out, norm2_g, w_ffn_in, w_ffn_out, final_g):

    def layer(x, l, cond, rope, ctx_k, ctx_v):
        B, L, _ = x.shape
        sh1, sc1, g1, sh2, sc2, g2 = ada_modulation(cond, w_ada[l], b_ada[l])
        h = rms_norm(x, norm1_g[l]) * (1.0 + sc1) + sh1
        p_pool, p_q, p_k, p_v, p_uv = jnp.split(h @ w_in[l], SPLITS, axis=-1)

        pooled = multiscale_pool(p_pool).reshape(B, L, N_POOL_GROUPS, POOL_GROUP)
        y_a = jnp.einsum('blgc,gcd->blgd', pooled, w_pool[l]).reshape(B, L, POOL_WIDTH) * pool_scale[l]

        q = p_q.reshape(B, L, N_HEADS, 2, QK_DIM)
        k = p_k.reshape(B, L, N_HEADS, 2, QK_DIM)
        q1, q2, k1, k2 = q[..., 0, :], q[..., 1, :], k[..., 0, :], k[..., 1, :]
        if rope is not None:
            q1, q2, k1, k2 = (apply_axial_rope(t, *rope) for t in (q1, q2, k1, k2))
        k_cat = jnp.concatenate([k1, k2], axis=-1)
        v = p_v.reshape(B, L, N_HEADS, V_DIM)
        if ctx_k is not None:
            k_all = jnp.concatenate([ctx_k, k_cat], axis=1)
            v_all = jnp.concatenate([ctx_v, v], axis=1)
        else:
            k_all, v_all = k_cat, v
        lam_init = 0.8 - 0.6 * math.exp(-0.3 * l)
        lam = (jnp.exp(jnp.sum(lam_q1[l].astype(jnp.float32) * lam_k1[l].astype(jnp.float32)))
               - jnp.exp(jnp.sum(lam_q2[l].astype(jnp.float32) * lam_k2[l].astype(jnp.float32)))
               + lam_init)
        y_b = diff_attention(q1, q2, k_all[..., :QK_DIM], k_all[..., QK_DIM:], v_all, lam)
        y_b = (rms_norm(y_b, subln_g[l]) * (1.0 - lam_init)).reshape(B, L, ATTN_WIDTH)

        y_c = chunk_spatial_gating(p_uv, sgu_norm_g[l], w_sgu[l], b_sgu[l])

        y = jnp.concatenate([y_a, y_b, y_c], axis=-1) @ w_out[l]
        x = x + g1 * y
        h2 = rms_norm(x, norm2_g[l]) * (1.0 + sc2) + sh2
        gate, up = jnp.split(h2 @ w_ffn_in[l], 2, axis=-1)
        x = x + g2 * ((jax.nn.silu(gate) * up) @ w_ffn_out[l])
        return x, k_cat, v

    cond_ctx = c_ctx[None, :]
    xp = x_prompt
    ks_new, vs_new = [], []
    for l in range(DEPTH):
        xp, k_l, v_l = layer(xp, l, cond_ctx, None, None, None)
        ks_new.append(k_l)
        vs_new.append(v_l)
    y_prompt = rms_norm(xp, final_g)
    new_cache_k = jnp.stack(ks_new, axis=1)
    new_cache_v = jnp.stack(vs_new, axis=1)

    rope = axial_rope_tables(x_sample.shape[1])
    xs = x_sample
    for l in range(DEPTH):
        xs, _, _ = layer(xs, l, c, rope, cache_k[:, l], cache_v[:, l])
    y_sample = rms_norm(xs, final_g)

    return (y_prompt, y_sample, new_cache_k, new_cache_v)
```

```cpp
#include <hip/hip_runtime.h>
#include <cstdio>
#include <cstdint>

#define LAS __attribute__((address_space(3)))
typedef unsigned short bf16;
typedef float f32x4 __attribute__((ext_vector_type(4)));
typedef unsigned u32x4 __attribute__((ext_vector_type(4)));
typedef unsigned u32x2 __attribute__((ext_vector_type(2)));

constexpr int D = 1024, MP = 4096, MS = 8192, M = MP + MS;
constexpr int LP = 256, LS = 1024, PAST = 256, LKS = PAST + LS;
constexpr int NIN = 2304, DFF = 2816, NMOD = 6 * D, NCOND = 9;
constexpr int NTHREADS = 512, NWAVES = 8;
constexpr float EPS = 1e-6f;
constexpr float QSCALE = 0.125f * 1.4426950408889634f;
constexpr int C_POOL = 0, C_Q = 256, C_K = 768, C_V = 1280, C_U = 1792, C_VG = 2048;
constexpr size_t OUT_YP = 0, OUT_YS = (size_t)MP * D, OUT_K = (size_t)M * D, OUT_V = OUT_K + (size_t)16 * 2 * 256 * 512;

constexpr size_t MiB = 1u << 20;
constexpr size_t WS_CTL = 0;
constexpr size_t WS_MOD = 1 * MiB;
constexpr size_t WS_ROPE = WS_MOD + 512 * 1024;
constexpr size_t WS_LAM = WS_ROPE + 16 * 1024;
constexpr size_t WS_WIN = 2 * MiB;
constexpr size_t WS_WOUT = WS_WIN + (size_t)2 * NIN * D * 2;
constexpr size_t WS_WF1 = WS_WOUT + (size_t)2 * D * D * 2;
constexpr size_t WS_WF2 = WS_WF1 + (size_t)2 * 2 * DFF * D * 2;
constexpr size_t WS_H = WS_WF2 + (size_t)2 * D * DFF * 2;
constexpr size_t WS_Q = WS_H + (size_t)M * D * 2;
constexpr size_t WS_KP = WS_Q + (size_t)M * 512 * 2;
constexpr size_t WS_KS = WS_KP + (size_t)16 * 256 * 512 * 2;
constexpr size_t WS_VTP = WS_KS + (size_t)8 * LKS * 512 * 2;
constexpr size_t WS_VTS = WS_VTP + (size_t)16 * 4 * 128 * 256 * 2;
constexpr size_t WS_PP = WS_VTS + (size_t)8 * 4 * 128 * LKS * 2;
constexpr size_t WS_U = WS_PP + (size_t)M * 256 * 2;
constexpr size_t WS_VG = WS_U + (size_t)M * 256 * 2;
constexpr size_t WS_MIX = WS_VG + (size_t)M * 256 * 2;
constexpr size_t WS_ACT = WS_MIX + (size_t)M * D * 2;
constexpr size_t WS_END = WS_ACT + (size_t)M * DFF * 2;
static_assert(WS_END <= 256 * MiB, "d_ws map exceeds 256 MiB");

constexpr int LDS_BYTES = 147456;

__device__ __forceinline__ unsigned f2bf(float f) { unsigned u = __builtin_bit_cast(unsigned, f); return (u + 0x7fffu + ((u >> 16) & 1u)) >> 16; }
__device__ __forceinline__ unsigned pk2(float lo, float hi) { return f2bf(lo) | (f2bf(hi) << 16); }
__device__ __forceinline__ float bf2f(unsigned b) { return __builtin_bit_cast(float, b << 16); }
__device__ __forceinline__ float bflo(unsigned w) { return __builtin_bit_cast(float, w << 16); }
__device__ __forceinline__ float bfhi(unsigned w) { return __builtin_bit_cast(float, w & 0xffff0000u); }
__device__ __forceinline__ float wave_sum(float v) {
#pragma unroll
    for (int o = 1; o < 64; o <<= 1) v += __shfl_xor(v, o);
    return v;
}
__device__ __forceinline__ float wave_max(float v) {
#pragma unroll
    for (int o = 1; o < 64; o <<= 1) v = fmaxf(v, __shfl_xor(v, o));
    return v;
}
__device__ __forceinline__ int perm16(int t) { return (t & ~12) | ((t & 4) << 1) | ((t & 8) >> 1); }
__device__ __forceinline__ float gelu_tanh(float x) {
    const float u = 0.7978845608028654f * (x + 0.044715f * x * x * x);
    const float e = __expf(2.0f * u);
    const float t = 1.0f - 2.0f / (e + 1.0f);
    return 0.5f * x * (1.0f + t);
}
__device__ __forceinline__ float silu_f(float x) { return x / (1.0f + __expf(-x)); }
__device__ __forceinline__ int cond_of_row(int m) { return m < MP ? 8 : ((m - MP) >> 10); }

struct Args {
    const float* in[25];
    float* out;
    unsigned char* ws;
    int ph_lo, ph_hi;
};

struct Frame {
    LAS unsigned char* lds;
    int tid, lane, wave;
    const float* const* in;
    float* out;
    unsigned char* ws;
};

__device__ __forceinline__ void p0_ada(const Args& a, Frame& F) {
    LAS float* sc = (LAS float*)F.lds;
    LAS float* red = sc + NCOND * D;
    const float* c = a.in[4]; const float* cctx = a.in[5];
    const float* w_ada = a.in[7]; const float* b_ada = a.in[8];
    float* mod = (float*)(a.ws + WS_MOD);
    bool have = false;
    for (int item = blockIdx.x; item < 2 * 96; item += gridDim.x) {
        if (!have) {
            for (int i = F.tid; i < NCOND * D; i += NTHREADS) { const int b = i >> 10, k = i & 1023; const float v = (b < 8) ? c[b * D + k] : cctx[k]; sc[i] = silu_f(v); }
            have = true;
        }
        __syncthreads();
        const int l = item / 96, n = (item % 96) * 64 + F.lane;
        const float* wp = w_ada + (size_t)l * D * NMOD + n;
        float acc[NCOND];
#pragma unroll
        for (int b = 0; b < NCOND; ++b) acc[b] = 0.f;
        const int k0 = F.wave * 128;
#pragma unroll 4
        for (int kk = 0; kk < 128; kk += 4) {
            const int k = k0 + kk;
            const float w0 = wp[(size_t)(k + 0) * NMOD], w1 = wp[(size_t)(k + 1) * NMOD], w2 = wp[(size_t)(k + 2) * NMOD], w3 = wp[(size_t)(k + 3) * NMOD];
#pragma unroll
            for (int b = 0; b < NCOND; ++b) { const f32x4 s = *(const LAS f32x4*)(sc + b * D + k); acc[b] += s.x * w0 + s.y * w1 + s.z * w2 + s.w * w3; }
        }
#pragma unroll
        for (int b = 0; b < NCOND; ++b) red[(F.wave * NCOND + b) * 64 + F.lane] = acc[b];
        __syncthreads();
        for (int i = F.tid; i < NCOND * 64; i += NTHREADS) {
            const int b = i >> 6, ln = i & 63; float s = 0.f;
#pragma unroll
            for (int w = 0; w < 8; ++w) s += red[(w * NCOND + b) * 64 + ln];
            const int nn = (item % 96) * 64 + ln;
            mod[((size_t)l * NCOND + b) * NMOD + nn] = s + b_ada[(size_t)l * NMOD + nn];
        }
        __syncthreads();
    }
    __syncthreads();
}
__device__ __forceinline__ void p0_transpose_item(const float* W, int K, int N, bf16* WT, int swz_ffn, LAS float* scr, int item, int lane) {
    const int nblk = N / 32, kb = item / nblk, nb = item % nblk, k0 = 64 * kb, n0 = 32 * nb;
#pragma unroll 8
    for (int i = 0; i < 32; ++i) { const int kk = 2 * i + (lane >> 5); scr[kk * 33 + (lane & 31)] = W[(size_t)(k0 + kk) * N + n0 + (lane & 31)]; }
    asm volatile("s_waitcnt lgkmcnt(0)" ::: "memory");
    int r0 = n0;
    if (swz_ffn) { r0 = (n0 < DFF) ? ((n0 >> 7) * 256 + (n0 & 127)) : (((n0 - DFF) >> 7) * 256 + 128 + ((n0 - DFF) & 127)); }
    const int c = lane & 7;
#pragma unroll
    for (int j = 0; j < 4; ++j) { const int n = (lane >> 3) + 8 * j; const LAS float* s = scr + (8 * c) * 33 + n;
        u32x4 o; o.x = pk2(s[0 * 33], s[1 * 33]); o.y = pk2(s[2 * 33], s[3 * 33]); o.z = pk2(s[4 * 33], s[5 * 33]); o.w = pk2(s[6 * 33], s[7 * 33]);
        *(u32x4*)(WT + (size_t)(r0 + n) * K + k0 + 8 * c) = o; }
    asm volatile("s_waitcnt lgkmcnt(0)" ::: "memory");
}
__device__ __forceinline__ void p0_weights(const Args& a, Frame& F) {
    LAS float* scr = (LAS float*)(F.lds) + F.wave * (64 * 33);
    const int gw = blockIdx.x * NWAVES + F.wave, NGW = gridDim.x * NWAVES;
    constexpr int I_IN = (D / 64) * (NIN / 32), I_OUT = (D / 64) * (D / 32), I_F1 = (D / 64) * (2 * DFF / 32), I_F2 = (DFF / 64) * (D / 32);
    constexpr int PER_L = I_IN + I_OUT + I_F1 + I_F2;
    for (int it = gw; it < 2 * PER_L; it += NGW) {
        const int l = it / PER_L; int r = it % PER_L;
        if (r < I_IN) { p0_transpose_item(a.in[9] + (size_t)l * D * NIN, D, NIN, (bf16*)(a.ws + WS_WIN) + (size_t)l * NIN * D, 0, scr, r, F.lane); continue; } r -= I_IN;
        if (r < I_OUT) { p0_transpose_item(a.in[20] + (size_t)l * D * D, D, D, (bf16*)(a.ws + WS_WOUT) + (size_t)l * D * D, 0, scr, r, F.lane); continue; } r -= I_OUT;
        if (r < I_F1) { p0_transpose_item(a.in[22] + (size_t)l * D * 2 * DFF, D, 2 * DFF, (bf16*)(a.ws + WS_WF1) + (size_t)l * 2 * DFF * D, 1, scr, r, F.lane); continue; } r -= I_F1;
        p0_transpose_item(a.in[23] + (size_t)l * DFF * D, DFF, D, (bf16*)(a.ws + WS_WF2) + (size_t)l * D * DFF, 0, scr, r, F.lane);
    }
}
__device__ __forceinline__ void p0_misc(const Args& a, Frame& F) {
    if (blockIdx.x == gridDim.x - 1) {
        float* rope = (float*)(a.ws + WS_ROPE);
        for (int i = F.tid; i < 64 * 16; i += NTHREADS) {
            const int pos = i >> 4, fi = i & 15;
            const float inv = (float)(1.0 / pow(10000.0, (double)fi / 16.0));
            const float ang = (float)pos * inv;
            rope[i] = (float)cos((double)ang); rope[1024 + i] = (float)sin((double)ang);
        }
        if (F.wave == 0) {
            float* lam = (float*)(a.ws + WS_LAM);
#pragma unroll
            for (int l = 0; l < 2; ++l) {
                const float d1 = wave_sum(a.in[12][l * 64 + F.lane] * a.in[13][l * 64 + F.lane]);
                const float d2 = wave_sum(a.in[14][l * 64 + F.lane] * a.in[15][l * 64 + F.lane]);
                const float lam_init = (l == 0) ? 0.2f : (float)(0.8 - 0.6 * 0.7408182206817179);
                if (F.lane == 0) lam[l] = expf(d1) - expf(d2) + lam_init;
            }
        }
    }
}

__device__ __forceinline__ const float* xrow_ptr(const Args& a, int l_first, int m) {
    if (l_first) return (m < MP) ? a.in[0] + (size_t)m * D : a.in[1] + (size_t)(m - MP) * D;
    return a.out + (size_t)m * D;
}
__device__ __forceinline__ void norm_phase(const Args& a, Frame& F, int l, int which  ) {
    const float* g = (which == 0 ? a.in[6] : a.in[21]) + (size_t)l * D;
    const float* mod = (const float*)(a.ws + WS_MOD) + (size_t)l * NCOND * NMOD;
    const int sh_off = which == 0 ? 0 : 3 * D, sc_off = which == 0 ? D : 4 * D;
    bf16* H = (bf16*)(a.ws + WS_H);
    const int gw = blockIdx.x * NWAVES + F.wave, NGW = gridDim.x * NWAVES;
    for (int m = gw; m < M; m += NGW) {
        const f32x4* xr = (const f32x4*)xrow_ptr(a, (l == 0 && which == 0), m) + F.lane;
        f32x4 v[4]; float s = 0.f;
#pragma unroll
        for (int j = 0; j < 4; ++j) { v[j] = xr[64 * j]; s += (v[j].x * v[j].x + v[j].y * v[j].y) + (v[j].z * v[j].z + v[j].w * v[j].w); }
        const float rstd = 1.0f / sqrtf(wave_sum(s) * (1.0f / D) + EPS);
        const float* mb = mod + (size_t)cond_of_row(m) * NMOD;
        unsigned long long* o8 = (unsigned long long*)(H + (size_t)m * D) + F.lane;
#pragma unroll
        for (int j = 0; j < 4; ++j) {
            const int col = 4 * (64 * j + F.lane);
            const f32x4 gv = *(const f32x4*)(g + col), scv = *(const f32x4*)(mb + sc_off + col), shv = *(const f32x4*)(mb + sh_off + col);
            const float y0 = v[j].x * rstd * gv.x * (1.0f + scv.x) + shv.x, y1 = v[j].y * rstd * gv.y * (1.0f + scv.y) + shv.y;
            const float y2 = v[j].z * rstd * gv.z * (1.0f + scv.z) + shv.z, y3 = v[j].w * rstd * gv.w * (1.0f + scv.w) + shv.w;
            o8[64 * j] = (unsigned long long)pk2(y0, y1) | ((unsigned long long)pk2(y2, y3) << 32);
        }
    }
}
__device__ __forceinline__ void cache_phase(const Args& a, Frame& F, int l) {
    const float* ck = a.in[2]; const float* cv = a.in[3];
    bf16* KS = (bf16*)(a.ws + WS_KS); bf16* VTS = (bf16*)(a.ws + WS_VTS);
    const int gt = blockIdx.x * NTHREADS + F.tid, NT = gridDim.x * NTHREADS;
    for (int i = gt; i < 8 * 256 * 128; i += NT) {
        const int b = i / (256 * 128), r = i % (256 * 128), pos = r / 128, c4 = (r % 128) * 4;
        const f32x4 v = *(const f32x4*)(ck + (((size_t)(b * 2 + l) * 256 + pos) * 512 + c4));
        *(u32x2*)(KS + ((size_t)(b * LKS + pos) * 512 + c4)) = (u32x2){pk2(v.x, v.y), pk2(v.z, v.w)};
    }
    for (int i = gt; i < 8 * 4 * 128 * 256; i += NT) {
        const int pp = i & 255, d = (i >> 8) & 127, h = (i >> 15) & 3, b = i >> 17;
        const int pos = perm16(pp);
        const float v = cv[((size_t)(b * 2 + l) * 256 + pos) * 512 + h * 128 + d];
        VTS[((size_t)(b * 4 + h) * 128 + d) * LKS + pp] = (bf16)f2bf(v);
    }
}

template <int TX, class Epi>
__device__ __forceinline__ void ref_gemm(LAS unsigned char* lds, const bf16* A, const bf16* Bt, int Mr, int N, int K, const Epi& epi) {
    constexpr int TY = NTHREADS / TX, BMn = 4 * TY, BNn = 4 * TX;
    LAS float* As = (LAS float*)lds;
    LAS float* Bs = As + BMn * 33;
    const int tid = threadIdx.x, tx = tid % TX, ty = tid / TX;
    const int ntn = N / BNn, ntm = Mr / BMn;
    for (int tile = blockIdx.x; tile < ntm * ntn; tile += gridDim.x) {
        const int tm = tile / ntn, tn = tile % ntn;
        float acc[4][4];
#pragma unroll
        for (int i = 0; i < 4; ++i)
#pragma unroll
            for (int j = 0; j < 4; ++j) acc[i][j] = 0.f;
        for (int k0 = 0; k0 < K; k0 += 32) {
            __syncthreads();
            for (int ch = tid; ch < BMn * 4; ch += NTHREADS) { const int r = ch >> 2, c8 = (ch & 3) * 8;
                const u32x4 v = *(const u32x4*)(A + (size_t)(tm * BMn + r) * K + k0 + c8); LAS float* d = As + r * 33 + c8;
                d[0] = bflo(v.x); d[1] = bfhi(v.x); d[2] = bflo(v.y); d[3] = bfhi(v.y); d[4] = bflo(v.z); d[5] = bfhi(v.z); d[6] = bflo(v.w); d[7] = bfhi(v.w); }
            for (int ch = tid; ch < BNn * 4; ch += NTHREADS) { const int r = ch >> 2, c8 = (ch & 3) * 8;
                const u32x4 v = *(const u32x4*)(Bt + (size_t)(tn * BNn + r) * K + k0 + c8); LAS float* d = Bs + r * 33 + c8;
                d[0] = bflo(v.x); d[1] = bfhi(v.x); d[2] = bflo(v.y); d[3] = bfhi(v.y); d[4] = bflo(v.z); d[5] = bfhi(v.z); d[6] = bflo(v.w); d[7] = bfhi(v.w); }
            __syncthreads();
#pragma unroll 8
            for (int kk = 0; kk < 32; ++kk) {
                float av[4], bv[4];
#pragma unroll
                for (int i = 0; i < 4; ++i) av[i] = As[(ty + TY * i) * 33 + kk];
#pragma unroll
                for (int j = 0; j < 4; ++j) bv[j] = Bs[(tx + TX * j) * 33 + kk];
#pragma unroll
                for (int i = 0; i < 4; ++i)
#pragma unroll
                    for (int j = 0; j < 4; ++j) acc[i][j] += av[i] * bv[j];
            }
        }
#pragma unroll
        for (int i = 0; i < 4; ++i) epi(tm * BMn + ty + TY * i, tn * BNn, tx, acc[i]);
    }
    __syncthreads();
}

struct EpiIn {
    const Args* a; int l;
    __device__ __forceinline__ void operator()(int m, int cb, int tx, const float (&v)[4]) const {
        unsigned char* ws = a->ws;
        const bool smp = m >= MP;
        const int b = smp ? ((m - MP) >> 10) : (m >> 8), t = smp ? ((m - MP) & 1023) : (m & 255);
        if (cb < C_Q) {
            bf16* P = (bf16*)(ws + WS_PP) + (size_t)m * 256 + cb + tx;
#pragma unroll
            for (int j = 0; j < 4; ++j) P[16 * j] = (bf16)f2bf(v[j]);
        } else if (cb < C_V) {
            float o[4] = {v[0], v[1], v[2], v[3]};
            if (smp) {
                const float* rope = (const float*)(ws + WS_ROPE);
                const int pr = t >> 6, pc = t & 63;
                const float cr = rope[pr * 16 + tx], sr = rope[1024 + pr * 16 + tx], cc = rope[pc * 16 + tx], sn = rope[1024 + pc * 16 + tx];
                o[0] = v[0] * cr - v[1] * sr; o[1] = v[1] * cr + v[0] * sr;
                o[2] = v[2] * cc - v[3] * sn; o[3] = v[3] * cc + v[2] * sn;
            }
            if (cb < C_K) {
                bf16* Q = (bf16*)(ws + WS_Q) + (size_t)m * 512 + (cb - C_Q) + tx;
#pragma unroll
                for (int j = 0; j < 4; ++j) Q[16 * j] = (bf16)f2bf(o[j] * QSCALE);
            } else {
                const int col = (cb - C_K) + tx;
                bf16* Kd = smp ? (bf16*)(ws + WS_KS) + ((size_t)(b * LKS + PAST + t) * 512 + col) : (bf16*)(ws + WS_KP) + ((size_t)(b * LP + t) * 512 + col);
#pragma unroll
                for (int j = 0; j < 4; ++j) Kd[16 * j] = (bf16)f2bf(o[j]);
                if (!smp) { float* ok = a->out + OUT_K + ((size_t)(b * 2 + l) * 256 + t) * 512 + col;
#pragma unroll
                    for (int j = 0; j < 4; ++j) ok[16 * j] = o[j]; }
            }
        } else if (cb < C_U) {
#pragma unroll
            for (int j = 0; j < 4; ++j) {
                const int col = (cb - C_V) + tx + 16 * j, h = col >> 7, d = col & 127;
                if (smp) ((bf16*)(ws + WS_VTS))[((size_t)(b * 4 + h) * 128 + d) * LKS + PAST + perm16(t)] = (bf16)f2bf(v[j]);
                else { ((bf16*)(ws + WS_VTP))[((size_t)(b * 4 + h) * 128 + d) * LP + perm16(t)] = (bf16)f2bf(v[j]);
                       a->out[OUT_V + ((size_t)(b * 2 + l) * 256 + t) * 512 + col] = v[j]; }
            }
        } else {
            bf16* U = (cb < C_VG) ? (bf16*)(ws + WS_U) + (size_t)m * 256 + (cb - C_U) + tx : (bf16*)(ws + WS_VG) + (size_t)m * 256 + (cb - C_VG) + tx;
#pragma unroll
            for (int j = 0; j < 4; ++j) U[16 * j] = (bf16)f2bf(gelu_tanh(v[j]));
        }
    }
};
struct EpiRes {
    const Args* a; int l; int gi; int first;
    __device__ __forceinline__ void operator()(int m, int cb, int tx, const float (&v)[4]) const {
        const float* src = xrow_ptr(*a, first, m);
        const float* gate = (const float*)(a->ws + WS_MOD) + ((size_t)l * NCOND + cond_of_row(m)) * NMOD + gi * D;
        float* X = a->out + (size_t)m * D;
#pragma unroll
        for (int j = 0; j < 4; ++j) { const int n = cb + tx + 16 * j; X[n] = src[n] + gate[n] * v[j]; }
    }
};
struct EpiSwiglu {
    const Args* a;
    __device__ __forceinline__ void operator()(int m, int cb, int tx, const float (&v)[4]) const {
        bf16* ACT = (bf16*)(a->ws + WS_ACT) + (size_t)m * DFF + (cb >> 1) + tx;
        ACT[0] = (bf16)f2bf(silu_f(v[0]) * v[2]);
        ACT[64] = (bf16)f2bf(silu_f(v[1]) * v[3]);
    }
};

__device__ __forceinline__ void attn_ref(const Args& a, Frame& F, int l) {
    LAS float* wq = (LAS float*)F.lds + F.wave * (128 + 3 * LKS);
    LAS float* ws1 = wq + 128;
    LAS float* ws2 = ws1 + LKS;
    LAS float* wp = ws2 + LKS;
    const bf16* Q = (const bf16*)(a.ws + WS_Q);
    bf16* MIX = (bf16*)(a.ws + WS_MIX);
    const float lam = ((const float*)(a.ws + WS_LAM))[l];
    const float lam_init = (l == 0) ? 0.2f : (float)(0.8 - 0.6 * 0.7408182206817179);
    const float* subg = a.in[16] + l * 128;
    const int gw = blockIdx.x * NWAVES + F.wave, NGW = gridDim.x * NWAVES;
#pragma unroll 1
    for (int it = gw; it < M * 4; it += NGW) {
        const int m = it >> 2, h = it & 3;
        const bool smp = m >= MP;
        const int b = smp ? ((m - MP) >> 10) : (m >> 8);
        const int Lk = smp ? LKS : LP, nk = Lk >> 6;
        const bf16* Kb = smp ? (const bf16*)(a.ws + WS_KS) + (size_t)b * LKS * 512 + h * 128 : (const bf16*)(a.ws + WS_KP) + (size_t)b * LP * 512 + h * 128;
        const bf16* Vb = smp ? (const bf16*)(a.ws + WS_VTS) + (size_t)(b * 4 + h) * 128 * LKS : (const bf16*)(a.ws + WS_VTP) + (size_t)(b * 4 + h) * 128 * LP;
        wq[F.lane] = bf2f(Q[(size_t)m * 512 + h * 128 + F.lane]); wq[64 + F.lane] = bf2f(Q[(size_t)m * 512 + h * 128 + 64 + F.lane]);
        asm volatile("s_waitcnt lgkmcnt(0)" ::: "memory");
        float m1 = -1e30f, m2 = -1e30f;
#pragma unroll 1
        for (int kk = 0; kk < nk; ++kk) {
            const u32x4* kr = (const u32x4*)(Kb + (size_t)(kk * 64 + F.lane) * 512);
            float d1 = 0.f, d2 = 0.f;
#pragma unroll
            for (int c = 0; c < 8; ++c) {
                const u32x4 k1 = kr[c], k2 = kr[8 + c];
                const f32x4 qa = *(const LAS f32x4*)(wq + 8 * c), qb = *(const LAS f32x4*)(wq + 8 * c + 4);
                const f32x4 qc = *(const LAS f32x4*)(wq + 64 + 8 * c), qd = *(const LAS f32x4*)(wq + 64 + 8 * c + 4);
                d1 += qa.x * bflo(k1.x) + qa.y * bfhi(k1.x) + qa.z * bflo(k1.y) + qa.w * bfhi(k1.y) + qb.x * bflo(k1.z) + qb.y * bfhi(k1.z) + qb.z * bflo(k1.w) + qb.w * bfhi(k1.w);
                d2 += qc.x * bflo(k2.x) + qc.y * bfhi(k2.x) + qc.z * bflo(k2.y) + qc.w * bfhi(k2.y) + qd.x * bflo(k2.z) + qd.y * bfhi(k2.z) + qd.z * bflo(k2.w) + qd.w * bfhi(k2.w);
            }
            ws1[kk * 64 + F.lane] = d1; ws2[kk * 64 + F.lane] = d2;
            m1 = fmaxf(m1, d1); m2 = fmaxf(m2, d2);
        }
        m1 = wave_max(m1); m2 = wave_max(m2);
        asm volatile("s_waitcnt lgkmcnt(0)" ::: "memory");
        float l1 = 0.f, l2 = 0.f;
#pragma unroll 1
        for (int kk = 0; kk < nk; ++kk) {
            const float e1 = exp2f(ws1[kk * 64 + F.lane] - m1), e2 = exp2f(ws2[kk * 64 + F.lane] - m2);
            ws1[kk * 64 + F.lane] = e1; ws2[kk * 64 + F.lane] = e2; l1 += e1; l2 += e2;
        }
        l1 = wave_sum(l1); l2 = wave_sum(l2);
        const float i1 = 1.0f / l1, i2 = lam / l2;
        asm volatile("s_waitcnt lgkmcnt(0)" ::: "memory");
#pragma unroll 1
        for (int kk = 0; kk < nk; ++kk) wp[perm16(kk * 64 + F.lane)] = ws1[kk * 64 + F.lane] * i1 - ws2[kk * 64 + F.lane] * i2;
        asm volatile("s_waitcnt lgkmcnt(0)" ::: "memory");
        float o0 = 0.f, o1 = 0.f;
        const bf16* v0 = Vb + (size_t)F.lane * Lk; const bf16* v1 = Vb + (size_t)(64 + F.lane) * Lk;
#pragma unroll 2
        for (int p = 0; p < Lk; p += 8) {
            const u32x4 a0 = *(const u32x4*)(v0 + p), a1 = *(const u32x4*)(v1 + p);
            const f32x4 pa = *(const LAS f32x4*)(wp + p), pb = *(const LAS f32x4*)(wp + p + 4);
            o0 += pa.x * bflo(a0.x) + pa.y * bfhi(a0.x) + pa.z * bflo(a0.y) + pa.w * bfhi(a0.y) + pb.x * bflo(a0.z) + pb.y * bfhi(a0.z) + pb.z * bflo(a0.w) + pb.w * bfhi(a0.w);
            o1 += pa.x * bflo(a1.x) + pa.y * bfhi(a1.x) + pa.z * bflo(a1.y) + pa.w * bfhi(a1.y) + pb.x * bflo(a1.z) + pb.y * bfhi(a1.z) + pb.z * bflo(a1.w) + pb.w * bfhi(a1.w);
        }
        const float ss = wave_sum(o0 * o0 + o1 * o1);
        const float r = (1.0f / sqrtf(ss * (1.0f / 128.0f) + EPS)) * (1.0f - lam_init);
        MIX[(size_t)m * D + 256 + h * 128 + F.lane] = (bf16)f2bf(o0 * r * subg[F.lane]);
        MIX[(size_t)m * D + 256 + h * 128 + 64 + F.lane] = (bf16)f2bf(o1 * r * subg[64 + F.lane]);
        asm volatile("s_waitcnt lgkmcnt(0)" ::: "memory");
    }
}
__device__ __forceinline__ void pool_phase(const Args& a, Frame& F, int l) {
    LAS float* P = (LAS float*)F.lds;
    LAS float* Qp = P + 48 * 256;
    LAS float* Wl = Qp + 32 * 256;
    const bf16* PP = (const bf16*)(a.ws + WS_PP);
    bf16* MIX = (bf16*)(a.ws + WS_MIX);
    const float* wpool = a.in[10] + (size_t)l * 4 * 64 * 64; const float* pscale = a.in[11] + l * 256;
    bool have = false;
#pragma unroll 1
    for (int unit = blockIdx.x; unit < M / 32; unit += gridDim.x) {
        const int m0 = unit * 32;
        const bool smp = m0 >= MP;
        const int L = smp ? LS : LP;
        const int t0 = smp ? ((m0 - MP) & 1023) : (m0 & 255);
        const int mseq = m0 - t0;
        __syncthreads();
        if (!have) { for (int i = F.tid; i < 4 * 64 * 64 / 4; i += NTHREADS) *(LAS f32x4*)(Wl + 4 * i) = *(const f32x4*)(wpool + 4 * i); have = true; }
#pragma unroll 1
        for (int i = F.tid; i < 48 * 64; i += NTHREADS) {
            const int r = i >> 6, c4 = (i & 63) * 4, t = t0 - 8 + r;
            f32x4 v = {0.f, 0.f, 0.f, 0.f};
            if (t >= 0 && t < L) { const u32x2 w = *(const u32x2*)(PP + (size_t)(mseq + t) * 256 + c4); v = (f32x4){bflo(w.x), bfhi(w.x), bflo(w.y), bfhi(w.y)}; }
            *(LAS f32x4*)(P + r * 256 + c4) = v;
        }
        __syncthreads();
#pragma unroll 1
        for (int i = F.tid; i < 32 * 256; i += NTHREADS) {
            const int tt = i >> 8, c = i & 255, g = c >> 6, hw = 1 << g;
            const int t = t0 + tt;
            int lo = t - hw; if (lo < 0) lo = 0;
            int hi = t + hw; if (hi > L) hi = L;
            float s = 0.f;
#pragma unroll 1
            for (int u = lo; u < hi; ++u) s += P[(u - t0 + 8) * 256 + c];
            Qp[tt * 256 + c] = s / (float)(hi - lo) - P[(tt + 8) * 256 + c];
        }
        __syncthreads();
        {
            const int d = F.tid & 63, g = (F.tid >> 6) & 3, half = F.tid >> 8;
            const float ps = pscale[g * 64 + d];
            const LAS float* wg = Wl + g * 4096 + d;
#pragma unroll 1
            for (int tt = half * 16; tt < half * 16 + 16; ++tt) {
                float acc = 0.f;
#pragma unroll 4
                for (int c = 0; c < 64; c += 4) { const f32x4 q = *(const LAS f32x4*)(Qp + tt * 256 + g * 64 + c);
                    acc += q.x * wg[(c + 0) * 64] + q.y * wg[(c + 1) * 64] + q.z * wg[(c + 2) * 64] + q.w * wg[(c + 3) * 64]; }
                MIX[(size_t)(m0 + tt) * D + g * 64 + d] = (bf16)f2bf(acc * ps);
            }
        }
    }
    __syncthreads();
}
__device__ __forceinline__ void sgu_ref(const Args& a, Frame& F, int l) {
    LAS float* vn = (LAS float*)F.lds;
    const bf16* VG = (const bf16*)(a.ws + WS_VG); const bf16* U = (const bf16*)(a.ws + WS_U);
    bf16* MIX = (bf16*)(a.ws + WS_MIX);
    const float* gn = a.in[17] + l * 256; const float* wsg = a.in[18] + (size_t)l * 4 * 128 * 128; const float* bsg = a.in[19] + l * 4 * 128;
    for (int unit = blockIdx.x; unit < M / 128; unit += gridDim.x) {
        const int m0 = unit * 128;
        __syncthreads();
        for (int q = F.wave; q < 128; q += NWAVES) {
            const u32x2 w = *(const u32x2*)(VG + (size_t)(m0 + q) * 256 + 4 * F.lane);
            const float x0 = bflo(w.x), x1 = bfhi(w.x), x2 = bflo(w.y), x3 = bfhi(w.y);
            const float mean = wave_sum((x0 + x1) + (x2 + x3)) * (1.0f / 256.0f);
            const float d0 = x0 - mean, d1 = x1 - mean, d2 = x2 - mean, d3 = x3 - mean;
            const float var = wave_sum((d0 * d0 + d1 * d1) + (d2 * d2 + d3 * d3)) * (1.0f / 256.0f);
            const float r = 1.0f / sqrtf(var + EPS);
            const f32x4 g4 = *(const f32x4*)(gn + 4 * F.lane);
            *(LAS f32x4*)(vn + q * 256 + 4 * F.lane) = (f32x4){d0 * r * g4.x, d1 * r * g4.y, d2 * r * g4.z, d3 * r * g4.w};
        }
        __syncthreads();
        const int c = F.tid & 255, ph = F.tid >> 8, g = c >> 6;
        for (int p = ph * 64; p < ph * 64 + 64; ++p) {
            const float* wr = wsg + ((size_t)g * 128 + p) * 128;
            float acc = bsg[g * 128 + p];
#pragma unroll 8
            for (int q = 0; q < 128; ++q) acc += wr[q] * vn[q * 256 + c];
            const float u = bf2f(U[(size_t)(m0 + p) * 256 + c]);
            MIX[(size_t)(m0 + p) * D + 768 + c] = (bf16)f2bf(u * acc);
        }
    }
    __syncthreads();
}
__device__ __forceinline__ void final_phase(const Args& a, Frame& F) {
    const float* g = a.in[24];
    const int gw = blockIdx.x * NWAVES + F.wave, NGW = gridDim.x * NWAVES;
    for (int m = gw; m < M; m += NGW) {
        f32x4* xr = (f32x4*)(a.out + (size_t)m * D) + F.lane;
        f32x4 v[4]; float s = 0.f;
#pragma unroll
        for (int j = 0; j < 4; ++j) { v[j] = xr[64 * j]; s += (v[j].x * v[j].x + v[j].y * v[j].y) + (v[j].z * v[j].z + v[j].w * v[j].w); }
        const float rstd = 1.0f / sqrtf(wave_sum(s) * (1.0f / D) + EPS);
#pragma unroll
        for (int j = 0; j < 4; ++j) { const f32x4 gv = *(const f32x4*)(g + 4 * (64 * j + F.lane)); xr[64 * j] = (f32x4){v[j].x * rstd * gv.x, v[j].y * rstd * gv.y, v[j].z * rstd * gv.z, v[j].w * rstd * gv.w}; }
    }
}

constexpr int NPHASES = 16;
#ifndef PHMASK
#define PHMASK 0xFFFF
#endif
#define PHM(k) ((PHMASK >> (k)) & 1)
__global__ void __launch_bounds__(NTHREADS, 2) mk_fwd(Args args) {
    extern __shared__ __attribute__((aligned(16))) unsigned char lds_raw[];
    Frame F;
    F.lds = (LAS unsigned char*)lds_raw;
    F.tid = threadIdx.x; F.lane = F.tid & 63; F.wave = __builtin_amdgcn_readfirstlane(F.tid >> 6);
    const int lo = args.ph_lo, hi = args.ph_hi;
#define IN(k) (lo <= (k) && (k) < hi)
    if (IN(0)) { if (PHM(0)) { p0_ada(args, F); p0_weights(args, F); p0_misc(args, F); } }
#pragma unroll 1
    for (int l = 0; l < 2; ++l) {
        const int pb = 1 + 7 * l;
        if (IN(pb + 0)) { if (PHM(1)) { norm_phase(args, F, l, 0); cache_phase(args, F, l); } }
        if (IN(pb + 1)) { if (PHM(2)) { EpiIn E{&args, l}; ref_gemm<16, EpiIn>(F.lds, (const bf16*)(args.ws + WS_H), (const bf16*)(args.ws + WS_WIN) + (size_t)l * NIN * D, M, NIN, D, E); } }
        if (IN(pb + 2)) { if (PHM(3)) { attn_ref(args, F, l); __syncthreads(); } if (PHM(9)) pool_phase(args, F, l); if (PHM(10)) sgu_ref(args, F, l); }
        if (IN(pb + 3)) { if (PHM(4)) { EpiRes E{&args, l, 2, l == 0 ? 1 : 0}; ref_gemm<16, EpiRes>(F.lds, (const bf16*)(args.ws + WS_MIX), (const bf16*)(args.ws + WS_WOUT) + (size_t)l * D * D, M, D, D, E); } }
        if (IN(pb + 4)) { if (PHM(5)) norm_phase(args, F, l, 1); }
        if (IN(pb + 5)) { if (PHM(6)) { EpiSwiglu E{&args}; ref_gemm<64, EpiSwiglu>(F.lds, (const bf16*)(args.ws + WS_H), (const bf16*)(args.ws + WS_WF1) + (size_t)l * 2 * DFF * D, M, 2 * DFF, D, E); } }
        if (IN(pb + 6)) { if (PHM(7)) { EpiRes E{&args, l, 5, 0}; ref_gemm<16, EpiRes>(F.lds, (const bf16*)(args.ws + WS_ACT), (const bf16*)(args.ws + WS_WF2) + (size_t)l * D * DFF, M, D, DFF, E); } }
    }
    if (IN(15)) { if (PHM(8)) final_phase(args, F); }
#undef IN
}

extern "C" void kernel_launch(void* const* d_in, const int* in_sizes, int n_in, void* d_out, int out_size, void* d_ws, size_t ws_size, hipStream_t stream) {
    static int grid = 0;
    if (grid == 0) {
        if (n_in != 25 || ws_size < WS_END) { fprintf(stderr, "kernel_launch: expected 25 inputs and >= %zu bytes of workspace; got %d, %zu\n", (size_t)WS_END, n_in, ws_size); grid = -1; return; }
        int dev = 0, cus = 0;
        if (hipGetDevice(&dev) != hipSuccess || hipDeviceGetAttribute(&cus, hipDeviceAttributeMultiprocessorCount, dev) != hipSuccess) { grid = -1; return; }
        if (hipFuncSetAttribute((const void*)mk_fwd, hipFuncAttributeMaxDynamicSharedMemorySize, LDS_BYTES) != hipSuccess) { fprintf(stderr, "kernel_launch: hipFuncSetAttribute failed\n"); grid = -1; return; }
        grid = cus;
    }
    if (grid < 0) return;
    Args a{};
    for (int i = 0; i < 25; ++i) a.in[i] = (const float*)d_in[i];
    a.out = (float*)d_out; a.ws = (unsigned char*)d_ws;
    for (int ph = 0; ph < NPHASES; ++ph) {
        a.ph_lo = ph; a.ph_hi = ph + 1;
        hipLaunchKernelGGL(mk_fwd, dim3(grid), dim3(NTHREADS), LDS_BYTES, stream, a);
    }
}
```

```cpp
#include <hip/hip_runtime.h>
#include <cstdio>
#include <cstdint>

#define LAS __attribute__((address_space(3)))
typedef unsigned short bf16;
typedef float f32x4 __attribute__((ext_vector_type(4)));
typedef unsigned u32x4 __attribute__((ext_vector_type(4)));
typedef unsigned u32x2 __attribute__((ext_vector_type(2)));

constexpr int D = 1024, MP = 4096, MS = 8192, M = MP + MS;
constexpr int LP = 256, LS = 1024, PAST = 256, LKS = PAST + LS;
constexpr int NIN = 2304, DFF = 2816, NMOD = 6 * D, NCOND = 9;
constexpr int NTHREADS = 512, NWAVES = 8;
constexpr float EPS = 1e-6f;
constexpr float QSCALE = 0.125f * 1.4426950408889634f;
constexpr int C_POOL = 0, C_Q = 256, C_K = 768, C_V = 1280, C_U = 1792, C_VG = 2048;
constexpr size_t OUT_YP = 0, OUT_YS = (size_t)MP * D, OUT_K = (size_t)M * D, OUT_V = OUT_K + (size_t)16 * 2 * 256 * 512;

constexpr size_t MiB = 1u << 20;
constexpr size_t WS_CTL = 0;
constexpr size_t WS_MOD = 1 * MiB;
constexpr size_t WS_ROPE = WS_MOD + 512 * 1024;
constexpr size_t WS_LAM = WS_ROPE + 16 * 1024;
constexpr size_t WS_WIN = 2 * MiB;
constexpr size_t WS_WOUT = WS_WIN + (size_t)2 * NIN * D * 2;
constexpr size_t WS_WF1 = WS_WOUT + (size_t)2 * D * D * 2;
constexpr size_t WS_WF2 = WS_WF1 + (size_t)2 * 2 * DFF * D * 2;
constexpr size_t WS_H = WS_WF2 + (size_t)2 * D * DFF * 2;
constexpr size_t WS_Q = WS_H + (size_t)M * D * 2;
constexpr size_t WS_KP = WS_Q + (size_t)M * 512 * 2;
constexpr size_t WS_KS = WS_KP + (size_t)16 * 256 * 512 * 2;
constexpr size_t WS_VTP = WS_KS + (size_t)8 * LKS * 512 * 2;
constexpr size_t WS_VTS = WS_VTP + (size_t)16 * 4 * 128 * 256 * 2;
constexpr size_t WS_PP = WS_VTS + (size_t)8 * 4 * 128 * LKS * 2;
constexpr size_t WS_U = WS_PP + (size_t)M * 256 * 2;
constexpr size_t WS_VG = WS_U + (size_t)M * 256 * 2;
constexpr size_t WS_MIX = WS_VG + (size_t)M * 256 * 2;
constexpr size_t WS_ACT = WS_MIX + (size_t)M * D * 2;
constexpr size_t WS_END = WS_ACT + (size_t)M * DFF * 2;
static_assert(WS_END <= 256 * MiB, "d_ws map exceeds 256 MiB");

constexpr int PHASE_LDS = 147456;
constexpr int LDSCTL_OFF = PHASE_LDS;
constexpr int LDS_BYTES = PHASE_LDS + 1024;
constexpr int CW_BAR = 4096;
constexpr size_t CTL_ZERO_BYTES = 65536;
#ifndef N_LAUNCHES
#define N_LAUNCHES 1
#endif

__device__ __forceinline__ unsigned f2bf(float f) { unsigned u = __builtin_bit_cast(unsigned, f); return (u + 0x7fffu + ((u >> 16) & 1u)) >> 16; }
__device__ __forceinline__ unsigned pk2(float lo, float hi) { return f2bf(lo) | (f2bf(hi) << 16); }
__device__ __forceinline__ float bf2f(unsigned b) { return __builtin_bit_cast(float, b << 16); }
__device__ __forceinline__ float bflo(unsigned w) { return __builtin_bit_cast(float, w << 16); }
__device__ __forceinline__ float bfhi(unsigned w) { return __builtin_bit_cast(float, w & 0xffff0000u); }
__device__ __forceinline__ float wave_sum(float v) {
#pragma unroll
    for (int o = 1; o < 64; o <<= 1) v += __shfl_xor(v, o);
    return v;
}
__device__ __forceinline__ float wave_max(float v) {
#pragma unroll
    for (int o = 1; o < 64; o <<= 1) v = fmaxf(v, __shfl_xor(v, o));
    return v;
}
__device__ __forceinline__ int perm16(int t) { return (t & ~12) | ((t & 4) << 1) | ((t & 8) >> 1); }
__device__ __forceinline__ float gelu_tanh(float x) {
    const float u = 0.7978845608028654f * (x + 0.044715f * x * x * x);
    const float e = __expf(2.0f * u);
    const float t = 1.0f - 2.0f / (e + 1.0f);
    return 0.5f * x * (1.0f + t);
}
__device__ __forceinline__ float silu_f(float x) { return x / (1.0f + __expf(-x)); }
__device__ __forceinline__ int cond_of_row(int m) { return m < MP ? 8 : ((m - MP) >> 10); }

struct Args {
    const float* in[25];
    float* out;
    unsigned char* ws;
    int ph_lo, ph_hi;
};

struct Frame {
    LAS unsigned char* lds;
    int tid, lane, wave;
    const float* const* in;
    float* out;
    unsigned char* ws;
};

__device__ __forceinline__ void p0_ada(const Args& a, Frame& F) {
    LAS float* sc = (LAS float*)F.lds;
    LAS float* red = sc + NCOND * D;
    const float* c = a.in[4]; const float* cctx = a.in[5];
    const float* w_ada = a.in[7]; const float* b_ada = a.in[8];
    float* mod = (float*)(a.ws + WS_MOD);
    bool have = false;
    for (int item = blockIdx.x; item < 2 * 96; item += gridDim.x) {
        if (!have) {
            for (int i = F.tid; i < NCOND * D; i += NTHREADS) { const int b = i >> 10, k = i & 1023; const float v = (b < 8) ? c[b * D + k] : cctx[k]; sc[i] = silu_f(v); }
            have = true;
        }
        __syncthreads();
        const int l = item / 96, n = (item % 96) * 64 + F.lane;
        const float* wp = w_ada + (size_t)l * D * NMOD + n;
        float acc[NCOND];
#pragma unroll
        for (int b = 0; b < NCOND; ++b) acc[b] = 0.f;
        const int k0 = F.wave * 128;
#pragma unroll 4
        for (int kk = 0; kk < 128; kk += 4) {
            const int k = k0 + kk;
            const float w0 = wp[(size_t)(k + 0) * NMOD], w1 = wp[(size_t)(k + 1) * NMOD], w2 = wp[(size_t)(k + 2) * NMOD], w3 = wp[(size_t)(k + 3) * NMOD];
#pragma unroll
            for (int b = 0; b < NCOND; ++b) { const f32x4 s = *(const LAS f32x4*)(sc + b * D + k); acc[b] += s.x * w0 + s.y * w1 + s.z * w2 + s.w * w3; }
        }
#pragma unroll
        for (int b = 0; b < NCOND; ++b) red[(F.wave * NCOND + b) * 64 + F.lane] = acc[b];
        __syncthreads();
        for (int i = F.tid; i < NCOND * 64; i += NTHREADS) {
            const int b = i >> 6, ln = i & 63; float s = 0.f;
#pragma unroll
            for (int w = 0; w < 8; ++w) s += red[(w * NCOND + b) * 64 + ln];
            const int nn = (item % 96) * 64 + ln;
            mod[((size_t)l * NCOND + b) * NMOD + nn] = s + b_ada[(size_t)l * NMOD + nn];
        }
        __syncthreads();
    }
    __syncthreads();
}
__device__ __forceinline__ void p0_transpose_item(const float* W, int K, int N, bf16* WT, int swz_ffn, LAS float* scr, int item, int lane) {
    const int nblk = N / 32, kb = item / nblk, nb = item % nblk, k0 = 64 * kb, n0 = 32 * nb;
#pragma unroll 8
    for (int i = 0; i < 32; ++i) { const int kk = 2 * i + (lane >> 5); scr[kk * 33 + (lane & 31)] = W[(size_t)(k0 + kk) * N + n0 + (lane & 31)]; }
    asm volatile("s_waitcnt lgkmcnt(0)" ::: "memory");
    int r0 = n0;
    if (swz_ffn) { r0 = (n0 < DFF) ? ((n0 >> 7) * 256 + (n0 & 127)) : (((n0 - DFF) >> 7) * 256 + 128 + ((n0 - DFF) & 127)); }
    const int c = lane & 7;
#pragma unroll
    for (int j = 0; j < 4; ++j) { const int n = (lane >> 3) + 8 * j; const LAS float* s = scr + (8 * c) * 33 + n;
        u32x4 o; o.x = pk2(s[0 * 33], s[1 * 33]); o.y = pk2(s[2 * 33], s[3 * 33]); o.z = pk2(s[4 * 33], s[5 * 33]); o.w = pk2(s[6 * 33], s[7 * 33]);
        *(u32x4*)(WT + (size_t)(r0 + n) * K + k0 + 8 * c) = o; }
    asm volatile("s_waitcnt lgkmcnt(0)" ::: "memory");
}
__device__ __forceinline__ void p0_weights(const Args& a, Frame& F) {
    LAS float* scr = (LAS float*)(F.lds) + F.wave * (64 * 33);
    const int gw = blockIdx.x * NWAVES + F.wave, NGW = gridDim.x * NWAVES;
    constexpr int I_IN = (D / 64) * (NIN / 32), I_OUT = (D / 64) * (D / 32), I_F1 = (D / 64) * (2 * DFF / 32), I_F2 = (DFF / 64) * (D / 32);
    constexpr int PER_L = I_IN + I_OUT + I_F1 + I_F2;
    for (int it = gw; it < 2 * PER_L; it += NGW) {
        const int l = it / PER_L; int r = it % PER_L;
        if (r < I_IN) { p0_transpose_item(a.in[9] + (size_t)l * D * NIN, D, NIN, (bf16*)(a.ws + WS_WIN) + (size_t)l * NIN * D, 0, scr, r, F.lane); continue; } r -= I_IN;
        if (r < I_OUT) { p0_transpose_item(a.in[20] + (size_t)l * D * D, D, D, (bf16*)(a.ws + WS_WOUT) + (size_t)l * D * D, 0, scr, r, F.lane); continue; } r -= I_OUT;
        if (r < I_F1) { p0_transpose_item(a.in[22] + (size_t)l * D * 2 * DFF, D, 2 * DFF, (bf16*)(a.ws + WS_WF1) + (size_t)l * 2 * DFF * D, 1, scr, r, F.lane); continue; } r -= I_F1;
        p0_transpose_item(a.in[23] + (size_t)l * DFF * D, DFF, D, (bf16*)(a.ws + WS_WF2) + (size_t)l * D * DFF, 0, scr, r, F.lane);
    }
}
__device__ __forceinline__ void p0_misc(const Args& a, Frame& F) {
    if (blockIdx.x == gridDim.x - 1) {
        float* rope = (float*)(a.ws + WS_ROPE);
        for (int i = F.tid; i < 64 * 16; i += NTHREADS) {
            const int pos = i >> 4, fi = i & 15;
            const float inv = (float)(1.0 / pow(10000.0, (double)fi / 16.0));
            const float ang = (float)pos * inv;
            rope[i] = (float)cos((double)ang); rope[1024 + i] = (float)sin((double)ang);
        }
        if (F.wave == 0) {
            float* lam = (float*)(a.ws + WS_LAM);
#pragma unroll
            for (int l = 0; l < 2; ++l) {
                const float d1 = wave_sum(a.in[12][l * 64 + F.lane] * a.in[13][l * 64 + F.lane]);
                const float d2 = wave_sum(a.in[14][l * 64 + F.lane] * a.in[15][l * 64 + F.lane]);
                const float lam_init = (l == 0) ? 0.2f : (float)(0.8 - 0.6 * 0.7408182206817179);
                if (F.lane == 0) lam[l] = expf(d1) - expf(d2) + lam_init;
            }
        }
    }
}

__device__ __forceinline__ const float* xrow_ptr(const Args& a, int l_first, int m) {
    if (l_first) return (m < MP) ? a.in[0] + (size_t)m * D : a.in[1] + (size_t)(m - MP) * D;
    return a.out + (size_t)m * D;
}
__device__ __forceinline__ void norm_phase(const Args& a, Frame& F, int l, int which  ) {
    const float* g = (which == 0 ? a.in[6] : a.in[21]) + (size_t)l * D;
    const float* mod = (const float*)(a.ws + WS_MOD) + (size_t)l * NCOND * NMOD;
    const int sh_off = which == 0 ? 0 : 3 * D, sc_off = which == 0 ? D : 4 * D;
    bf16* H = (bf16*)(a.ws + WS_H);
    const int gw = blockIdx.x * NWAVES + F.wave, NGW = gridDim.x * NWAVES;
    for (int m = gw; m < M; m += NGW) {
        const f32x4* xr = (const f32x4*)xrow_ptr(a, (l == 0 && which == 0), m) + F.lane;
        f32x4 v[4]; float s = 0.f;
#pragma unroll
        for (int j = 0; j < 4; ++j) { v[j] = xr[64 * j]; s += (v[j].x * v[j].x + v[j].y * v[j].y) + (v[j].z * v[j].z + v[j].w * v[j].w); }
        const float rstd = 1.0f / sqrtf(wave_sum(s) * (1.0f / D) + EPS);
        const float* mb = mod + (size_t)cond_of_row(m) * NMOD;
        unsigned long long* o8 = (unsigned long long*)(H + (size_t)m * D) + F.lane;
#pragma unroll
        for (int j = 0; j < 4; ++j) {
            const int col = 4 * (64 * j + F.lane);
            const f32x4 gv = *(const f32x4*)(g + col), scv = *(const f32x4*)(mb + sc_off + col), shv = *(const f32x4*)(mb + sh_off + col);
            const float y0 = v[j].x * rstd * gv.x * (1.0f + scv.x) + shv.x, y1 = v[j].y * rstd * gv.y * (1.0f + scv.y) + shv.y;
            const float y2 = v[j].z * rstd * gv.z * (1.0f + scv.z) + shv.z, y3 = v[j].w * rstd * gv.w * (1.0f + scv.w) + shv.w;
            o8[64 * j] = (unsigned long long)pk2(y0, y1) | ((unsigned long long)pk2(y2, y3) << 32);
        }
    }
}
__device__ __forceinline__ void cache_phase(const Args& a, Frame& F, int l) {
    const float* ck = a.in[2]; const float* cv = a.in[3];
    bf16* KS = (bf16*)(a.ws + WS_KS); bf16* VTS = (bf16*)(a.ws + WS_VTS);
    const int gt = blockIdx.x * NTHREADS + F.tid, NT = gridDim.x * NTHREADS;
    for (int i = gt; i < 8 * 256 * 128; i += NT) {
        const int b = i / (256 * 128), r = i % (256 * 128), pos = r / 128, c4 = (r % 128) * 4;
        const f32x4 v = *(const f32x4*)(ck + (((size_t)(b * 2 + l) * 256 + pos) * 512 + c4));
        *(u32x2*)(KS + ((size_t)(b * LKS + pos) * 512 + c4)) = (u32x2){pk2(v.x, v.y), pk2(v.z, v.w)};
    }
    for (int i = gt; i < 8 * 4 * 128 * 256; i += NT) {
        const int pp = i & 255, d = (i >> 8) & 127, h = (i >> 15) & 3, b = i >> 17;
        const int pos = perm16(pp);
        const float v = cv[((size_t)(b * 2 + l) * 256 + pos) * 512 + h * 128 + d];
        VTS[((size_t)(b * 4 + h) * 128 + d) * LKS + pp] = (bf16)f2bf(v);
    }
}

template <int TX, class Epi>
__device__ __forceinline__ void ref_gemm(LAS unsigned char* lds, const bf16* A, const bf16* Bt, int Mr, int N, int K, const Epi& epi) {
    constexpr int TY = NTHREADS / TX, BMn = 4 * TY, BNn = 4 * TX;
    LAS float* As = (LAS float*)lds;
    LAS float* Bs = As + BMn * 33;
    const int tid = threadIdx.x, tx = tid % TX, ty = tid / TX;
    const int ntn = N / BNn, ntm = Mr / BMn;
    for (int tile = blockIdx.x; tile < ntm * ntn; tile += gridDim.x) {
        const int tm = tile / ntn, tn = tile % ntn;
        float acc[4][4];
#pragma unroll
        for (int i = 0; i < 4; ++i)
#pragma unroll
            for (int j = 0; j < 4; ++j) acc[i][j] = 0.f;
        for (int k0 = 0; k0 < K; k0 += 32) {
            __syncthreads();
            for (int ch = tid; ch < BMn * 4; ch += NTHREADS) { const int r = ch >> 2, c8 = (ch & 3) * 8;
                const u32x4 v = *(const u32x4*)(A + (size_t)(tm * BMn + r) * K + k0 + c8); LAS float* d = As + r * 33 + c8;
                d[0] = bflo(v.x); d[1] = bfhi(v.x); d[2] = bflo(v.y); d[3] = bfhi(v.y); d[4] = bflo(v.z); d[5] = bfhi(v.z); d[6] = bflo(v.w); d[7] = bfhi(v.w); }
            for (int ch = tid; ch < BNn * 4; ch += NTHREADS) { const int r = ch >> 2, c8 = (ch & 3) * 8;
                const u32x4 v = *(const u32x4*)(Bt + (size_t)(tn * BNn + r) * K + k0 + c8); LAS float* d = Bs + r * 33 + c8;
                d[0] = bflo(v.x); d[1] = bfhi(v.x); d[2] = bflo(v.y); d[3] = bfhi(v.y); d[4] = bflo(v.z); d[5] = bfhi(v.z); d[6] = bflo(v.w); d[7] = bfhi(v.w); }
            __syncthreads();
#pragma unroll 8
            for (int kk = 0; kk < 32; ++kk) {
                float av[4], bv[4];
#pragma unroll
                for (int i = 0; i < 4; ++i) av[i] = As[(ty + TY * i) * 33 + kk];
#pragma unroll
                for (int j = 0; j < 4; ++j) bv[j] = Bs[(tx + TX * j) * 33 + kk];
#pragma unroll
                for (int i = 0; i < 4; ++i)
#pragma unroll
                    for (int j = 0; j < 4; ++j) acc[i][j] += av[i] * bv[j];
            }
        }
#pragma unroll
        for (int i = 0; i < 4; ++i) epi(tm * BMn + ty + TY * i, tn * BNn, tx, acc[i]);
    }
    __syncthreads();
}

struct EpiIn {
    const Args* a; int l;
    __device__ __forceinline__ void operator()(int m, int cb, int tx, const float (&v)[4]) const {
        unsigned char* ws = a->ws;
        const bool smp = m >= MP;
        const int b = smp ? ((m - MP) >> 10) : (m >> 8), t = smp ? ((m - MP) & 1023) : (m & 255);
        if (cb < C_Q) {
            bf16* P = (bf16*)(ws + WS_PP) + (size_t)m * 256 + cb + tx;
#pragma unroll
            for (int j = 0; j < 4; ++j) P[16 * j] = (bf16)f2bf(v[j]);
        } else if (cb < C_V) {
            float o[4] = {v[0], v[1], v[2], v[3]};
            if (smp) {
                const float* rope = (const float*)(ws + WS_ROPE);
                const int pr = t >> 6, pc = t & 63;
                const float cr = rope[pr * 16 + tx], sr = rope[1024 + pr * 16 + tx], cc = rope[pc * 16 + tx], sn = rope[1024 + pc * 16 + tx];
                o[0] = v[0] * cr - v[1] * sr; o[1] = v[1] * cr + v[0] * sr;
                o[2] = v[2] * cc - v[3] * sn; o[3] = v[3] * cc + v[2] * sn;
            }
            if (cb < C_K) {
                bf16* Q = (bf16*)(ws + WS_Q) + (size_t)m * 512 + (cb - C_Q) + tx;
#pragma unroll
                for (int j = 0; j < 4; ++j) Q[16 * j] = (bf16)f2bf(o[j] * QSCALE);
            } else {
                const int col = (cb - C_K) + tx;
                bf16* Kd = smp ? (bf16*)(ws + WS_KS) + ((size_t)(b * LKS + PAST + t) * 512 + col) : (bf16*)(ws + WS_KP) + ((size_t)(b * LP + t) * 512 + col);
#pragma unroll
                for (int j = 0; j < 4; ++j) Kd[16 * j] = (bf16)f2bf(o[j]);
                if (!smp) { float* ok = a->out + OUT_K + ((size_t)(b * 2 + l) * 256 + t) * 512 + col;
#pragma unroll
                    for (int j = 0; j < 4; ++j) ok[16 * j] = o[j]; }
            }
        } else if (cb < C_U) {
#pragma unroll
            for (int j = 0; j < 4; ++j) {
                const int col = (cb - C_V) + tx + 16 * j, h = col >> 7, d = col & 127;
                if (smp) ((bf16*)(ws + WS_VTS))[((size_t)(b * 4 + h) * 128 + d) * LKS + PAST + perm16(t)] = (bf16)f2bf(v[j]);
                else { ((bf16*)(ws + WS_VTP))[((size_t)(b * 4 + h) * 128 + d) * LP + perm16(t)] = (bf16)f2bf(v[j]);
                       a->out[OUT_V + ((size_t)(b * 2 + l) * 256 + t) * 512 + col] = v[j]; }
            }
        } else {
            bf16* U = (cb < C_VG) ? (bf16*)(ws + WS_U) + (size_t)m * 256 + (cb - C_U) + tx : (bf16*)(ws + WS_VG) + (size_t)m * 256 + (cb - C_VG) + tx;
#pragma unroll
            for (int j = 0; j < 4; ++j) U[16 * j] = (bf16)f2bf(gelu_tanh(v[j]));
        }
    }
};
struct EpiRes {
    const Args* a; int l; int gi; int first;
    __device__ __forceinline__ void operator()(int m, int cb, int tx, const float (&v)[4]) const {
        const float* src = xrow_ptr(*a, first, m);
        const float* gate = (const float*)(a->ws + WS_MOD) + ((size_t)l * NCOND + cond_of_row(m)) * NMOD + gi * D;
        float* X = a->out + (size_t)m * D;
#pragma unroll
        for (int j = 0; j < 4; ++j) { const int n = cb + tx + 16 * j; X[n] = src[n] + gate[n] * v[j]; }
    }
};
struct EpiSwiglu {
    const Args* a;
    __device__ __forceinline__ void operator()(int m, int cb, int tx, const float (&v)[4]) const {
        bf16* ACT = (bf16*)(a->ws + WS_ACT) + (size_t)m * DFF + (cb >> 1) + tx;
        ACT[0] = (bf16)f2bf(silu_f(v[0]) * v[2]);
        ACT[64] = (bf16)f2bf(silu_f(v[1]) * v[3]);
    }
};

__device__ __forceinline__ void attn_ref(const Args& a, Frame& F, int l) {
    LAS float* wq = (LAS float*)F.lds + F.wave * (128 + 3 * LKS);
    LAS float* ws1 = wq + 128;
    LAS float* ws2 = ws1 + LKS;
    LAS float* wp = ws2 + LKS;
    const bf16* Q = (const bf16*)(a.ws + WS_Q);
    bf16* MIX = (bf16*)(a.ws + WS_MIX);
    const float lam = ((const float*)(a.ws + WS_LAM))[l];
    const float lam_init = (l == 0) ? 0.2f : (float)(0.8 - 0.6 * 0.7408182206817179);
    const float* subg = a.in[16] + l * 128;
    const int gw = blockIdx.x * NWAVES + F.wave, NGW = gridDim.x * NWAVES;
#pragma unroll 1
    for (int it = gw; it < M * 4; it += NGW) {
        const int m = it >> 2, h = it & 3;
        const bool smp = m >= MP;
        const int b = smp ? ((m - MP) >> 10) : (m >> 8);
        const int Lk = smp ? LKS : LP, nk = Lk >> 6;
        const bf16* Kb = smp ? (const bf16*)(a.ws + WS_KS) + (size_t)b * LKS * 512 + h * 128 : (const bf16*)(a.ws + WS_KP) + (size_t)b * LP * 512 + h * 128;
        const bf16* Vb = smp ? (const bf16*)(a.ws + WS_VTS) + (size_t)(b * 4 + h) * 128 * LKS : (const bf16*)(a.ws + WS_VTP) + (size_t)(b * 4 + h) * 128 * LP;
        wq[F.lane] = bf2f(Q[(size_t)m * 512 + h * 128 + F.lane]); wq[64 + F.lane] = bf2f(Q[(size_t)m * 512 + h * 128 + 64 + F.lane]);
        asm volatile("s_waitcnt lgkmcnt(0)" ::: "memory");
        float m1 = -1e30f, m2 = -1e30f;
#pragma unroll 1
        for (int kk = 0; kk < nk; ++kk) {
            const u32x4* kr = (const u32x4*)(Kb + (size_t)(kk * 64 + F.lane) * 512);
            float d1 = 0.f, d2 = 0.f;
#pragma unroll
            for (int c = 0; c < 8; ++c) {
                const u32x4 k1 = kr[c], k2 = kr[8 + c];
                const f32x4 qa = *(const LAS f32x4*)(wq + 8 * c), qb = *(const LAS f32x4*)(wq + 8 * c + 4);
                const f32x4 qc = *(const LAS f32x4*)(wq + 64 + 8 * c), qd = *(const LAS f32x4*)(wq + 64 + 8 * c + 4);
                d1 += qa.x * bflo(k1.x) + qa.y * bfhi(k1.x) + qa.z * bflo(k1.y) + qa.w * bfhi(k1.y) + qb.x * bflo(k1.z) + qb.y * bfhi(k1.z) + qb.z * bflo(k1.w) + qb.w * bfhi(k1.w);
                d2 += qc.x * bflo(k2.x) + qc.y * bfhi(k2.x) + qc.z * bflo(k2.y) + qc.w * bfhi(k2.y) + qd.x * bflo(k2.z) + qd.y * bfhi(k2.z) + qd.z * bflo(k2.w) + qd.w * bfhi(k2.w);
            }
            ws1[kk * 64 + F.lane] = d1; ws2[kk * 64 + F.lane] = d2;
            m1 = fmaxf(m1, d1); m2 = fmaxf(m2, d2);
        }
        m1 = wave_max(m1); m2 = wave_max(m2);
        asm volatile("s_waitcnt lgkmcnt(0)" ::: "memory");
        float l1 = 0.f, l2 = 0.f;
#pragma unroll 1
        for (int kk = 0; kk < nk; ++kk) {
            const float e1 = exp2f(ws1[kk * 64 + F.lane] - m1), e2 = exp2f(ws2[kk * 64 + F.lane] - m2);
            ws1[kk * 64 + F.lane] = e1; ws2[kk * 64 + F.lane] = e2; l1 += e1; l2 += e2;
        }
        l1 = wave_sum(l1); l2 = wave_sum(l2);
        const float i1 = 1.0f / l1, i2 = lam / l2;
        asm volatile("s_waitcnt lgkmcnt(0)" ::: "memory");
#pragma unroll 1
        for (int kk = 0; kk < nk; ++kk) wp[perm16(kk * 64 + F.lane)] = ws1[kk * 64 + F.lane] * i1 - ws2[kk * 64 + F.lane] * i2;
        asm volatile("s_waitcnt lgkmcnt(0)" ::: "memory");
        float o0 = 0.f, o1 = 0.f;
        const bf16* v0 = Vb + (size_t)F.lane * Lk; const bf16* v1 = Vb + (size_t)(64 + F.lane) * Lk;
#pragma unroll 2
        for (int p = 0; p < Lk; p += 8) {
            const u32x4 a0 = *(const u32x4*)(v0 + p), a1 = *(const u32x4*)(v1 + p);
            const f32x4 pa = *(const LAS f32x4*)(wp + p), pb = *(const LAS f32x4*)(wp + p + 4);
            o0 += pa.x * bflo(a0.x) + pa.y * bfhi(a0.x) + pa.z * bflo(a0.y) + pa.w * bfhi(a0.y) + pb.x * bflo(a0.z) + pb.y * bfhi(a0.z) + pb.z * bflo(a0.w) + pb.w * bfhi(a0.w);
            o1 += pa.x * bflo(a1.x) + pa.y * bfhi(a1.x) + pa.z * bflo(a1.y) + pa.w * bfhi(a1.y) + pb.x * bflo(a1.z) + pb.y * bfhi(a1.z) + pb.z * bflo(a1.w) + pb.w * bfhi(a1.w);
        }
        const float ss = wave_sum(o0 * o0 + o1 * o1);
        const float r = (1.0f / sqrtf(ss * (1.0f / 128.0f) + EPS)) * (1.0f - lam_init);
        MIX[(size_t)m * D + 256 + h * 128 + F.lane] = (bf16)f2bf(o0 * r * subg[F.lane]);
        MIX[(size_t)m * D + 256 + h * 128 + 64 + F.lane] = (bf16)f2bf(o1 * r * subg[64 + F.lane]);
        asm volatile("s_waitcnt lgkmcnt(0)" ::: "memory");
    }
}
__device__ __forceinline__ void pool_phase(const Args& a, Frame& F, int l) {
    LAS float* P = (LAS float*)F.lds;
    LAS float* Qp = P + 48 * 256;
    LAS float* Wl = Qp + 32 * 256;
    const bf16* PP = (const bf16*)(a.ws + WS_PP);
    bf16* MIX = (bf16*)(a.ws + WS_MIX);
    const float* wpool = a.in[10] + (size_t)l * 4 * 64 * 64; const float* pscale = a.in[11] + l * 256;
    bool have = false;
#pragma unroll 1
    for (int unit = blockIdx.x; unit < M / 32; unit += gridDim.x) {
        const int m0 = unit * 32;
        const bool smp = m0 >= MP;
        const int L = smp ? LS : LP;
        const int t0 = smp ? ((m0 - MP) & 1023) : (m0 & 255);
        const int mseq = m0 - t0;
        __syncthreads();
        if (!have) { for (int i = F.tid; i < 4 * 64 * 64 / 4; i += NTHREADS) *(LAS f32x4*)(Wl + 4 * i) = *(const f32x4*)(wpool + 4 * i); have = true; }
#pragma unroll 1
        for (int i = F.tid; i < 48 * 64; i += NTHREADS) {
            const int r = i >> 6, c4 = (i & 63) * 4, t = t0 - 8 + r;
            f32x4 v = {0.f, 0.f, 0.f, 0.f};
            if (t >= 0 && t < L) { const u32x2 w = *(const u32x2*)(PP + (size_t)(mseq + t) * 256 + c4); v = (f32x4){bflo(w.x), bfhi(w.x), bflo(w.y), bfhi(w.y)}; }
            *(LAS f32x4*)(P + r * 256 + c4) = v;
        }
        __syncthreads();
#pragma unroll 1
        for (int i = F.tid; i < 32 * 256; i += NTHREADS) {
            const int tt = i >> 8, c = i & 255, g = c >> 6, hw = 1 << g;
            const int t = t0 + tt;
            int lo = t - hw; if (lo < 0) lo = 0;
            int hi = t + hw; if (hi > L) hi = L;
            float s = 0.f;
#pragma unroll 1
            for (int u = lo; u < hi; ++u) s += P[(u - t0 + 8) * 256 + c];
            Qp[tt * 256 + c] = s / (float)(hi - lo) - P[(tt + 8) * 256 + c];
        }
        __syncthreads();
        {
            const int d = F.tid & 63, g = (F.tid >> 6) & 3, half = F.tid >> 8;
            const float ps = pscale[g * 64 + d];
            const LAS float* wg = Wl + g * 4096 + d;
#pragma unroll 1
            for (int tt = half * 16; tt < half * 16 + 16; ++tt) {
                float acc = 0.f;
#pragma unroll 4
                for (int c = 0; c < 64; c += 4) { const f32x4 q = *(const LAS f32x4*)(Qp + tt * 256 + g * 64 + c);
                    acc += q.x * wg[(c + 0) * 64] + q.y * wg[(c + 1) * 64] + q.z * wg[(c + 2) * 64] + q.w * wg[(c + 3) * 64]; }
                MIX[(size_t)(m0 + tt) * D + g * 64 + d] = (bf16)f2bf(acc * ps);
            }
        }
    }
    __syncthreads();
}
__device__ __forceinline__ void sgu_ref(const Args& a, Frame& F, int l) {
    LAS float* vn = (LAS float*)F.lds;
    const bf16* VG = (const bf16*)(a.ws + WS_VG); const bf16* U = (const bf16*)(a.ws + WS_U);
    bf16* MIX = (bf16*)(a.ws + WS_MIX);
    const float* gn = a.in[17] + l * 256; const float* wsg = a.in[18] + (size_t)l * 4 * 128 * 128; const float* bsg = a.in[19] + l * 4 * 128;
    for (int unit = blockIdx.x; unit < M / 128; unit += gridDim.x) {
        const int m0 = unit * 128;
        __syncthreads();
        for (int q = F.wave; q < 128; q += NWAVES) {
            const u32x2 w = *(const u32x2*)(VG + (size_t)(m0 + q) * 256 + 4 * F.lane);
            const float x0 = bflo(w.x), x1 = bfhi(w.x), x2 = bflo(w.y), x3 = bfhi(w.y);
            const float mean = wave_sum((x0 + x1) + (x2 + x3)) * (1.0f / 256.0f);
            const float d0 = x0 - mean, d1 = x1 - mean, d2 = x2 - mean, d3 = x3 - mean;
            const float var = wave_sum((d0 * d0 + d1 * d1) + (d2 * d2 + d3 * d3)) * (1.0f / 256.0f);
            const float r = 1.0f / sqrtf(var + EPS);
            const f32x4 g4 = *(const f32x4*)(gn + 4 * F.lane);
            *(LAS f32x4*)(vn + q * 256 + 4 * F.lane) = (f32x4){d0 * r * g4.x, d1 * r * g4.y, d2 * r * g4.z, d3 * r * g4.w};
        }
        __syncthreads();
        const int c = F.tid & 255, ph = F.tid >> 8, g = c >> 6;
        for (int p = ph * 64; p < ph * 64 + 64; ++p) {
            const float* wr = wsg + ((size_t)g * 128 + p) * 128;
            float acc = bsg[g * 128 + p];
#pragma unroll 8
            for (int q = 0; q < 128; ++q) acc += wr[q] * vn[q * 256 + c];
            const float u = bf2f(U[(size_t)(m0 + p) * 256 + c]);
            MIX[(size_t)(m0 + p) * D + 768 + c] = (bf16)f2bf(u * acc);
        }
    }
    __syncthreads();
}
__device__ __forceinline__ void final_phase(const Args& a, Frame& F) {
    const float* g = a.in[24];
    const int gw = blockIdx.x * NWAVES + F.wave, NGW = gridDim.x * NWAVES;
    for (int m = gw; m < M; m += NGW) {
        f32x4* xr = (f32x4*)(a.out + (size_t)m * D) + F.lane;
        f32x4 v[4]; float s = 0.f;
#pragma unroll
        for (int j = 0; j < 4; ++j) { v[j] = xr[64 * j]; s += (v[j].x * v[j].x + v[j].y * v[j].y) + (v[j].z * v[j].z + v[j].w * v[j].w); }
        const float rstd = 1.0f / sqrtf(wave_sum(s) * (1.0f / D) + EPS);
#pragma unroll
        for (int j = 0; j < 4; ++j) { const f32x4 gv = *(const f32x4*)(g + 4 * (64 * j + F.lane)); xr[64 * j] = (f32x4){v[j].x * rstd * gv.x, v[j].y * rstd * gv.y, v[j].z * rstd * gv.z, v[j].w * rstd * gv.w}; }
    }
}

#define XB_TMO      128
#define XB_XCNT(j)  (256  + 64 * (j))
#define XB_XSUB(j)  (1280 + 64 * (j))
#define XB_XGEN(j)  (2304 + 64 * (j))
#define XB_TOP      3328
#define XB_TOPGEN   3392
#define XCD_BAR_WORDS 3456
#define XB_SPIN_CAP (1u << 20)
__device__ __forceinline__ unsigned xb_ld(unsigned* p)              { return __hip_atomic_load(p, __ATOMIC_RELAXED, __HIP_MEMORY_SCOPE_AGENT); }
__device__ __forceinline__ unsigned xb_add(unsigned* p, unsigned v) { return __hip_atomic_fetch_add(p, v, __ATOMIC_RELAXED, __HIP_MEMORY_SCOPE_AGENT); }
__device__ __forceinline__ unsigned xb_xcc_id() { return (unsigned)__builtin_amdgcn_s_getreg((3 << 11) | 20) & 0xFu; }
#define XB_SPIN(cond, bar) do { unsigned _sp = 0; while (cond) { __builtin_amdgcn_s_sleep(1); \
    if ((++_sp & 255u) == 0u) { if (xb_ld(&(bar)[XB_TMO])) break; if (_sp > XB_SPIN_CAP) { atomicAdd(&(bar)[XB_TMO], 1u); break; } } } } while (0)
struct XcdBarrier { unsigned* bar; unsigned x; volatile LAS unsigned* st; };
__device__ __forceinline__ XcdBarrier xcd_barrier_post(unsigned* bar, volatile LAS unsigned* st) {
    XcdBarrier b; b.bar = bar; b.x = xb_xcc_id(); b.st = st;
    if (threadIdx.x == 0) (void)xb_add(&bar[XB_XCNT(b.x)], 1u);
    return b;
}
__device__ __forceinline__ void xcd_barrier_complete(unsigned* bar, unsigned x, unsigned& nloc, unsigned& nx) {
    const unsigned G = gridDim.x * gridDim.y * gridDim.z;
    unsigned sum, cnt, mine, sp = 0u;
    for (;;) {
        sum = 0u; cnt = 0u; mine = 0u;
#pragma unroll
        for (unsigned j = 0; j < 16; ++j) { const unsigned c = xb_ld(&bar[XB_XCNT(j)]); sum += c; cnt += (c > 0u) ? 1u : 0u; mine = (j == x) ? c : mine; }
        if (sum == G) break;
        __builtin_amdgcn_s_sleep(1);
        if ((++sp & 255u) == 0u) { if (xb_ld(&bar[XB_TMO])) break; if (sp > XB_SPIN_CAP) { atomicAdd(&bar[XB_TMO], 1u); break; } }
    }
    nloc = mine > 0u ? mine : 1u; nx = cnt > 0u ? cnt : 1u;
}
__device__ __forceinline__ void xcd_barrier(const XcdBarrier& b) {
    asm volatile("s_waitcnt vmcnt(0)" ::: "memory");
    __syncthreads();
    if (threadIdx.x == 0) {
        unsigned* bar = b.bar;
        __builtin_amdgcn_s_waitcnt(0);
        unsigned nloc = b.st[0], nx = b.st[1];
        if (nloc == 0u) { xcd_barrier_complete(bar, b.x, nloc, nx); b.st[0] = nloc; b.st[1] = nx; }
        const unsigned old = xb_add(&bar[XB_XSUB(b.x)], 1u);
        const unsigned gen = old / nloc;
        if (old + 1u == (gen + 1u) * nloc) {
            __builtin_amdgcn_fence(__ATOMIC_RELEASE, "agent");
            asm volatile("s_waitcnt vmcnt(0)" ::: "memory");
            const unsigned og = xb_add(&bar[XB_TOP], 1u);
            const unsigned tg = og / nx;
            if (og + 1u == (tg + 1u) * nx) xb_add(&bar[XB_TOPGEN], 1u);
            else XB_SPIN(xb_ld(&bar[XB_TOPGEN]) == tg, bar);
            __builtin_amdgcn_fence(__ATOMIC_ACQUIRE, "agent");
            xb_add(&bar[XB_XGEN(b.x)], 1u);
            asm volatile("s_waitcnt vmcnt(0)" ::: "memory");
        } else {
            XB_SPIN(xb_ld(&bar[XB_XGEN(b.x)]) == gen, bar);
            __builtin_amdgcn_fence(__ATOMIC_ACQUIRE, "agent");
            asm volatile("s_waitcnt vmcnt(0)" ::: "memory");
        }
    }
    __syncthreads();
}

constexpr int NPHASES = 16;
#ifndef PHMASK
#define PHMASK 0xFFFF
#endif
#define PHM(k) ((PHMASK >> (k)) & 1)
__global__ void __launch_bounds__(NTHREADS, 2) mk_fwd(Args args) {
    extern __shared__ __attribute__((aligned(16))) unsigned char lds_raw[];
    Frame F;
    F.lds = (LAS unsigned char*)lds_raw;
    F.tid = threadIdx.x; F.lane = F.tid & 63; F.wave = __builtin_amdgcn_readfirstlane(F.tid >> 6);
    const int lo = args.ph_lo, hi = args.ph_hi;
    for (int u = F.tid; u < 256; u += NTHREADS) ((LAS unsigned*)(F.lds + LDSCTL_OFF))[u] = 0u;
    __syncthreads();
    XcdBarrier bar; bar.bar = (unsigned*)(args.ws + WS_CTL) + CW_BAR; bar.x = 0; bar.st = (volatile LAS unsigned*)(F.lds + LDSCTL_OFF) + 8;
    if (N_LAUNCHES == 1) bar = xcd_barrier_post((unsigned*)(args.ws + WS_CTL) + CW_BAR, (volatile LAS unsigned*)(F.lds + LDSCTL_OFF) + 8);
#define IN(k) (lo <= (k) && (k) < hi)
#define SEAM(k) do { if (N_LAUNCHES == 1 && IN(k) && IN((k) + 1)) xcd_barrier(bar); } while (0)
    if (IN(0)) { if (PHM(0)) { p0_ada(args, F); p0_weights(args, F); p0_misc(args, F); } }
    SEAM(0);
#pragma unroll 1
    for (int l = 0; l < 2; ++l) {
        const int pb = 1 + 7 * l;
        if (IN(pb + 0)) { if (PHM(1)) { norm_phase(args, F, l, 0); cache_phase(args, F, l); } }
        SEAM(pb + 0);
        if (IN(pb + 1)) { if (PHM(2)) { EpiIn E{&args, l}; ref_gemm<16, EpiIn>(F.lds, (const bf16*)(args.ws + WS_H), (const bf16*)(args.ws + WS_WIN) + (size_t)l * NIN * D, M, NIN, D, E); } }
        SEAM(pb + 1);
        if (IN(pb + 2)) { if (PHM(3)) { attn_ref(args, F, l); __syncthreads(); } if (PHM(9)) pool_phase(args, F, l); if (PHM(10)) sgu_ref(args, F, l); }
        SEAM(pb + 2);
        if (IN(pb + 3)) { if (PHM(4)) { EpiRes E{&args, l, 2, l == 0 ? 1 : 0}; ref_gemm<16, EpiRes>(F.lds, (const bf16*)(args.ws + WS_MIX), (const bf16*)(args.ws + WS_WOUT) + (size_t)l * D * D, M, D, D, E); } }
        SEAM(pb + 3);
        if (IN(pb + 4)) { if (PHM(5)) norm_phase(args, F, l, 1); }
        SEAM(pb + 4);
        if (IN(pb + 5)) { if (PHM(6)) { EpiSwiglu E{&args}; ref_gemm<64, EpiSwiglu>(F.lds, (const bf16*)(args.ws + WS_H), (const bf16*)(args.ws + WS_WF1) + (size_t)l * 2 * DFF * D, M, 2 * DFF, D, E); } }
        SEAM(pb + 5);
        if (IN(pb + 6)) { if (PHM(7)) { EpiRes E{&args, l, 5, 0}; ref_gemm<16, EpiRes>(F.lds, (const bf16*)(args.ws + WS_ACT), (const bf16*)(args.ws + WS_WF2) + (size_t)l * D * DFF, M, D, DFF, E); } }
        SEAM(pb + 6);
    }
    if (IN(15)) { if (PHM(8)) final_phase(args, F); }
#undef IN
#undef SEAM
}

extern "C" void kernel_launch(void* const* d_in, const int* in_sizes, int n_in, void* d_out, int out_size, void* d_ws, size_t ws_size, hipStream_t stream) {
    static int grid = 0;
    if (grid == 0) {
        if (n_in != 25 || ws_size < WS_END) { fprintf(stderr, "kernel_launch: expected 25 inputs and >= %zu bytes of workspace; got %d, %zu\n", (size_t)WS_END, n_in, ws_size); grid = -1; return; }
        int dev = 0, cus = 0;
        if (hipGetDevice(&dev) != hipSuccess || hipDeviceGetAttribute(&cus, hipDeviceAttributeMultiprocessorCount, dev) != hipSuccess) { grid = -1; return; }
        if (hipFuncSetAttribute((const void*)mk_fwd, hipFuncAttributeMaxDynamicSharedMemorySize, LDS_BYTES) != hipSuccess) { fprintf(stderr, "kernel_launch: hipFuncSetAttribute failed\n"); grid = -1; return; }
        grid = cus;
    }
    if (grid < 0) return;
    Args a{};
    for (int i = 0; i < 25; ++i) a.in[i] = (const float*)d_in[i];
    a.out = (float*)d_out; a.ws = (unsigned char*)d_ws;
    if (hipMemsetAsync((char*)d_ws + WS_CTL, 0, CTL_ZERO_BYTES, stream) != hipSuccess) { fprintf(stderr, "kernel_launch: hipMemsetAsync failed\n"); return; }
    if (N_LAUNCHES == 1) {
        a.ph_lo = 0; a.ph_hi = NPHASES;
        hipLaunchKernelGGL(mk_fwd, dim3(grid), dim3(NTHREADS), LDS_BYTES, stream, a);
    } else {
        for (int ph = 0; ph < NPHASES; ++ph) {
            a.ph_lo = ph; a.ph_hi = ph + 1;
            hipLaunchKernelGGL(mk_fwd, dim3(grid), dim3(NTHREADS), LDS_BYTES, stream, a);
        }
    }
}
```

```cpp
#include <hip/hip_runtime.h>
#include <cstdio>
#include <cstdint>

#define LAS __attribute__((address_space(3)))
typedef unsigned short bf16;
typedef float f32x4 __attribute__((ext_vector_type(4)));
typedef unsigned u32x4 __attribute__((ext_vector_type(4)));
typedef unsigned u32x2 __attribute__((ext_vector_type(2)));

constexpr int D = 1024, MP = 4096, MS = 8192, M = MP + MS;
constexpr int LP = 256, LS = 1024, PAST = 256, LKS = PAST + LS;
constexpr int NIN = 2304, DFF = 2816, NMOD = 6 * D, NCOND = 9;
constexpr int NTHREADS = 512, NWAVES = 8;
constexpr float EPS = 1e-6f;
constexpr float QSCALE = 0.125f * 1.4426950408889634f;
constexpr int C_POOL = 0, C_Q = 256, C_K = 768, C_V = 1280, C_U = 1792, C_VG = 2048;
constexpr size_t OUT_YP = 0, OUT_YS = (size_t)MP * D, OUT_K = (size_t)M * D, OUT_V = OUT_K + (size_t)16 * 2 * 256 * 512;

constexpr size_t MiB = 1u << 20;
constexpr size_t WS_CTL = 0;
constexpr size_t WS_MOD = 1 * MiB;
constexpr size_t WS_ROPE = WS_MOD + 512 * 1024;
constexpr size_t WS_LAM = WS_ROPE + 16 * 1024;
constexpr size_t WS_WIN = 2 * MiB;
constexpr size_t WS_WOUT = WS_WIN + (size_t)2 * NIN * D * 2;
constexpr size_t WS_WF1 = WS_WOUT + (size_t)2 * D * D * 2;
constexpr size_t WS_WF2 = WS_WF1 + (size_t)2 * 2 * DFF * D * 2;
constexpr size_t WS_H = WS_WF2 + (size_t)2 * D * DFF * 2;
constexpr size_t WS_Q = WS_H + (size_t)M * D * 2;
constexpr size_t WS_KP = WS_Q + (size_t)M * 512 * 2;
constexpr size_t WS_KS = WS_KP + (size_t)16 * 256 * 512 * 2;
constexpr size_t WS_VTP = WS_KS + (size_t)8 * LKS * 512 * 2;
constexpr size_t WS_VTS = WS_VTP + (size_t)16 * 4 * 128 * 256 * 2;
constexpr size_t WS_PP = WS_VTS + (size_t)8 * 4 * 128 * LKS * 2;
constexpr size_t WS_U = WS_PP + (size_t)M * 256 * 2;
constexpr size_t WS_VG = WS_U + (size_t)M * 256 * 2;
constexpr size_t WS_MIX = WS_VG + (size_t)M * 256 * 2;
constexpr size_t WS_ACT = WS_MIX + (size_t)M * D * 2;
constexpr size_t WS_END = WS_ACT + (size_t)M * DFF * 2;
static_assert(WS_END <= 256 * MiB, "d_ws map exceeds 256 MiB");

constexpr int PHASE_LDS = 147456;
constexpr int LDSCTL_OFF = PHASE_LDS;
constexpr int LDS_BYTES = PHASE_LDS + 1024;
constexpr int CW_BAR = 4096;
constexpr size_t CTL_ZERO_BYTES = 65536;
#ifndef N_LAUNCHES
#define N_LAUNCHES 1
#endif

__device__ __forceinline__ unsigned f2bf(float f) { unsigned u = __builtin_bit_cast(unsigned, f); return (u + 0x7fffu + ((u >> 16) & 1u)) >> 16; }
__device__ __forceinline__ unsigned pk2(float lo, float hi) { return f2bf(lo) | (f2bf(hi) << 16); }
__device__ __forceinline__ float bf2f(unsigned b) { return __builtin_bit_cast(float, b << 16); }
__device__ __forceinline__ float bflo(unsigned w) { return __builtin_bit_cast(float, w << 16); }
__device__ __forceinline__ float bfhi(unsigned w) { return __builtin_bit_cast(float, w & 0xffff0000u); }
__device__ __forceinline__ float wave_sum(float v) {
#pragma unroll
    for (int o = 1; o < 64; o <<= 1) v += __shfl_xor(v, o);
    return v;
}
__device__ __forceinline__ float wave_max(float v) {
#pragma unroll
    for (int o = 1; o < 64; o <<= 1) v = fmaxf(v, __shfl_xor(v, o));
    return v;
}
__device__ __forceinline__ int perm16(int t) { return (t & ~12) | ((t & 4) << 1) | ((t & 8) >> 1); }
__device__ __forceinline__ float gelu_tanh(float x) {
    const float u = 0.7978845608028654f * (x + 0.044715f * x * x * x);
    const float e = __expf(2.0f * u);
    const float t = 1.0f - 2.0f / (e + 1.0f);
    return 0.5f * x * (1.0f + t);
}
__device__ __forceinline__ float silu_f(float x) { return x / (1.0f + __expf(-x)); }
__device__ __forceinline__ int cond_of_row(int m) { return m < MP ? 8 : ((m - MP) >> 10); }

struct Args {
    const float* in[25];
    float* out;
    unsigned char* ws;
    int ph_lo, ph_hi;
};

struct Frame {
    LAS unsigned char* lds;
    int tid, lane, wave;
};
__device__ __forceinline__ const float* inp(const Frame& F, int i) {
    const LAS unsigned* t = (const LAS unsigned*)(F.lds + PHASE_LDS + 64) + 2 * i;
    const unsigned lo = __builtin_amdgcn_readfirstlane(t[0]), hi = __builtin_amdgcn_readfirstlane(t[1]);
    typedef __attribute__((address_space(1))) const float gcf;
    return (const float*)(gcf*)(((unsigned long long)hi << 32) | (unsigned long long)lo);
}

__device__ __forceinline__ void p0_ada(const Args& a, Frame& F) {
    LAS float* sc = (LAS float*)F.lds;
    LAS float* red = sc + NCOND * D;
    const float* c = inp(F, 4); const float* cctx = inp(F, 5);
    const float* w_ada = inp(F, 7); const float* b_ada = inp(F, 8);
    float* mod = (float*)(a.ws + WS_MOD);
    bool have = false;
    for (int item = blockIdx.x; item < 2 * 96; item += gridDim.x) {
        if (!have) {
            for (int i = F.tid; i < NCOND * D; i += NTHREADS) { const int b = i >> 10, k = i & 1023; const float v = (b < 8) ? c[b * D + k] : cctx[k]; sc[i] = silu_f(v); }
            have = true;
        }
        __syncthreads();
        const int l = item / 96, n = (item % 96) * 64 + F.lane;
        const float* wp = w_ada + (size_t)l * D * NMOD + n;
        float acc[NCOND];
#pragma unroll
        for (int b = 0; b < NCOND; ++b) acc[b] = 0.f;
        const int k0 = F.wave * 128;
#pragma unroll 4
        for (int kk = 0; kk < 128; kk += 4) {
            const int k = k0 + kk;
            const float w0 = wp[(size_t)(k + 0) * NMOD], w1 = wp[(size_t)(k + 1) * NMOD], w2 = wp[(size_t)(k + 2) * NMOD], w3 = wp[(size_t)(k + 3) * NMOD];
#pragma unroll
            for (int b = 0; b < NCOND; ++b) { const f32x4 s = *(const LAS f32x4*)(sc + b * D + k); acc[b] += s.x * w0 + s.y * w1 + s.z * w2 + s.w * w3; }
        }
#pragma unroll
        for (int b = 0; b < NCOND; ++b) red[(F.wave * NCOND + b) * 64 + F.lane] = acc[b];
        __syncthreads();
        for (int i = F.tid; i < NCOND * 64; i += NTHREADS) {
            const int b = i >> 6, ln = i & 63; float s = 0.f;
#pragma unroll
            for (int w = 0; w < 8; ++w) s += red[(w * NCOND + b) * 64 + ln];
            const int nn = (item % 96) * 64 + ln;
            mod[((size_t)l * NCOND + b) * NMOD + nn] = s + b_ada[(size_t)l * NMOD + nn];
        }
        __syncthreads();
    }
    __syncthreads();
}
__device__ __forceinline__ void p0_transpose_item(const float* W, int K, int N, bf16* WT, int swz_ffn, LAS float* scr, int item, int lane) {
    const int nblk = N / 32, kb = item / nblk, nb = item % nblk, k0 = 64 * kb, n0 = 32 * nb;
#pragma unroll 8
    for (int i = 0; i < 32; ++i) { const int kk = 2 * i + (lane >> 5); scr[kk * 33 + (lane & 31)] = W[(size_t)(k0 + kk) * N + n0 + (lane & 31)]; }
    asm volatile("s_waitcnt lgkmcnt(0)" ::: "memory");
    int r0 = n0;
    if (swz_ffn) { r0 = (n0 < DFF) ? ((n0 >> 7) * 256 + (n0 & 127)) : (((n0 - DFF) >> 7) * 256 + 128 + ((n0 - DFF) & 127)); }
    const int c = lane & 7;
#pragma unroll
    for (int j = 0; j < 4; ++j) { const int n = (lane >> 3) + 8 * j; const LAS float* s = scr + (8 * c) * 33 + n;
        u32x4 o; o.x = pk2(s[0 * 33], s[1 * 33]); o.y = pk2(s[2 * 33], s[3 * 33]); o.z = pk2(s[4 * 33], s[5 * 33]); o.w = pk2(s[6 * 33], s[7 * 33]);
        *(u32x4*)(WT + (size_t)(r0 + n) * K + k0 + 8 * c) = o; }
    asm volatile("s_waitcnt lgkmcnt(0)" ::: "memory");
}
__device__ __forceinline__ void p0_weights(const Args& a, Frame& F) {
    LAS float* scr = (LAS float*)(F.lds) + F.wave * (64 * 33);
    const int gw = blockIdx.x * NWAVES + F.wave, NGW = gridDim.x * NWAVES;
    constexpr int I_IN = (D / 64) * (NIN / 32), I_OUT = (D / 64) * (D / 32), I_F1 = (D / 64) * (2 * DFF / 32), I_F2 = (DFF / 64) * (D / 32);
    constexpr int PER_L = I_IN + I_OUT + I_F1 + I_F2;
    for (int it = gw; it < 2 * PER_L; it += NGW) {
        const int l = it / PER_L; int r = it % PER_L;
        if (r < I_IN) { p0_transpose_item(inp(F, 9) + (size_t)l * D * NIN, D, NIN, (bf16*)(a.ws + WS_WIN) + (size_t)l * NIN * D, 0, scr, r, F.lane); continue; } r -= I_IN;
        if (r < I_OUT) { p0_transpose_item(inp(F, 20) + (size_t)l * D * D, D, D, (bf16*)(a.ws + WS_WOUT) + (size_t)l * D * D, 0, scr, r, F.lane); continue; } r -= I_OUT;
        if (r < I_F1) { p0_transpose_item(inp(F, 22) + (size_t)l * D * 2 * DFF, D, 2 * DFF, (bf16*)(a.ws + WS_WF1) + (size_t)l * 2 * DFF * D, 1, scr, r, F.lane); continue; } r -= I_F1;
        p0_transpose_item(inp(F, 23) + (size_t)l * DFF * D, DFF, D, (bf16*)(a.ws + WS_WF2) + (size_t)l * D * DFF, 0, scr, r, F.lane);
    }
}
__device__ __forceinline__ void p0_misc(const Args& a, Frame& F) {
    if (blockIdx.x == gridDim.x - 1) {
        float* rope = (float*)(a.ws + WS_ROPE);
        for (int i = F.tid; i < 64 * 16; i += NTHREADS) {
            const int pos = i >> 4, fi = i & 15;
            const float inv = (float)(1.0 / pow(10000.0, (double)fi / 16.0));
            const float ang = (float)pos * inv;
            rope[i] = (float)cos((double)ang); rope[1024 + i] = (float)sin((double)ang);
        }
        if (F.wave == 0) {
            float* lam = (float*)(a.ws + WS_LAM);
#pragma unroll
            for (int l = 0; l < 2; ++l) {
                const float d1 = wave_sum(inp(F, 12)[l * 64 + F.lane] * inp(F, 13)[l * 64 + F.lane]);
                const float d2 = wave_sum(inp(F, 14)[l * 64 + F.lane] * inp(F, 15)[l * 64 + F.lane]);
                const float lam_init = (l == 0) ? 0.2f : (float)(0.8 - 0.6 * 0.7408182206817179);
                if (F.lane == 0) lam[l] = expf(d1) - expf(d2) + lam_init;
            }
        }
    }
}

__device__ __forceinline__ const float* xrow_ptr(const Args& a, const Frame& F, int l_first, int m) {
    if (l_first) return (m < MP) ? inp(F, 0) + (size_t)m * D : inp(F, 1) + (size_t)(m - MP) * D;
    return a.out + (size_t)m * D;
}
__device__ __forceinline__ void norm_phase(const Args& a, Frame& F, int l, int which  ) {
    const float* g = (which == 0 ? inp(F, 6) : inp(F, 21)) + (size_t)l * D;
    const float* mod = (const float*)(a.ws + WS_MOD) + (size_t)l * NCOND * NMOD;
    const int sh_off = which == 0 ? 0 : 3 * D, sc_off = which == 0 ? D : 4 * D;
    bf16* H = (bf16*)(a.ws + WS_H);
    const int gw = blockIdx.x * NWAVES + F.wave, NGW = gridDim.x * NWAVES;
    for (int m = gw; m < M; m += NGW) {
        const f32x4* xr = (const f32x4*)xrow_ptr(a, F, (l == 0 && which == 0), m) + F.lane;
        f32x4 v[4]; float s = 0.f;
#pragma unroll
        for (int j = 0; j < 4; ++j) { v[j] = xr[64 * j]; s += (v[j].x * v[j].x + v[j].y * v[j].y) + (v[j].z * v[j].z + v[j].w * v[j].w); }
        const float rstd = 1.0f / sqrtf(wave_sum(s) * (1.0f / D) + EPS);
        const float* mb = mod + (size_t)cond_of_row(m) * NMOD;
        unsigned long long* o8 = (unsigned long long*)(H + (size_t)m * D) + F.lane;
#pragma unroll
        for (int j = 0; j < 4; ++j) {
            const int col = 4 * (64 * j + F.lane);
            const f32x4 gv = *(const f32x4*)(g + col), scv = *(const f32x4*)(mb + sc_off + col), shv = *(const f32x4*)(mb + sh_off + col);
            const float y0 = v[j].x * rstd * gv.x * (1.0f + scv.x) + shv.x, y1 = v[j].y * rstd * gv.y * (1.0f + scv.y) + shv.y;
            const float y2 = v[j].z * rstd * gv.z * (1.0f + scv.z) + shv.z, y3 = v[j].w * rstd * gv.w * (1.0f + scv.w) + shv.w;
            o8[64 * j] = (unsigned long long)pk2(y0, y1) | ((unsigned long long)pk2(y2, y3) << 32);
        }
    }
}
__device__ __forceinline__ void cache_phase(const Args& a, Frame& F, int l) {
    const float* ck = inp(F, 2); const float* cv = inp(F, 3);
    bf16* KS = (bf16*)(a.ws + WS_KS); bf16* VTS = (bf16*)(a.ws + WS_VTS);
    const int gt = blockIdx.x * NTHREADS + F.tid, NT = gridDim.x * NTHREADS;
    for (int i = gt; i < 8 * 256 * 128; i += NT) {
        const int b = i / (256 * 128), r = i % (256 * 128), pos = r / 128, c4 = (r % 128) * 4;
        const f32x4 v = *(const f32x4*)(ck + (((size_t)(b * 2 + l) * 256 + pos) * 512 + c4));
        *(u32x2*)(KS + ((size_t)(b * LKS + pos) * 512 + c4)) = (u32x2){pk2(v.x, v.y), pk2(v.z, v.w)};
    }
    for (int i = gt; i < 8 * 4 * 128 * 256; i += NT) {
        const int pp = i & 255, d = (i >> 8) & 127, h = (i >> 15) & 3, b = i >> 17;
        const int pos = perm16(pp);
        const float v = cv[((size_t)(b * 2 + l) * 256 + pos) * 512 + h * 128 + d];
        VTS[((size_t)(b * 4 + h) * 128 + d) * LKS + pp] = (bf16)f2bf(v);
    }
}

template <int TX, class Epi>
__device__ __forceinline__ void ref_gemm(LAS unsigned char* lds, const bf16* A, const bf16* Bt, int Mr, int N, int K, const Epi& epi) {
    constexpr int TY = NTHREADS / TX, BMn = 4 * TY, BNn = 4 * TX;
    LAS float* As = (LAS float*)lds;
    LAS float* Bs = As + BMn * 33;
    const int tid = threadIdx.x, tx = tid % TX, ty = tid / TX;
    const int ntn = N / BNn, ntm = Mr / BMn;
    for (int tile = blockIdx.x; tile < ntm * ntn; tile += gridDim.x) {
        const int tm = tile / ntn, tn = tile % ntn;
        float acc[4][4];
#pragma unroll
        for (int i = 0; i < 4; ++i)
#pragma unroll
            for (int j = 0; j < 4; ++j) acc[i][j] = 0.f;
        for (int k0 = 0; k0 < K; k0 += 32) {
            __syncthreads();
            for (int ch = tid; ch < BMn * 4; ch += NTHREADS) { const int r = ch >> 2, c8 = (ch & 3) * 8;
                const u32x4 v = *(const u32x4*)(A + (size_t)(tm * BMn + r) * K + k0 + c8); LAS float* d = As + r * 33 + c8;
                d[0] = bflo(v.x); d[1] = bfhi(v.x); d[2] = bflo(v.y); d[3] = bfhi(v.y); d[4] = bflo(v.z); d[5] = bfhi(v.z); d[6] = bflo(v.w); d[7] = bfhi(v.w); }
            for (int ch = tid; ch < BNn * 4; ch += NTHREADS) { const int r = ch >> 2, c8 = (ch & 3) * 8;
                const u32x4 v = *(const u32x4*)(Bt + (size_t)(tn * BNn + r) * K + k0 + c8); LAS float* d = Bs + r * 33 + c8;
                d[0] = bflo(v.x); d[1] = bfhi(v.x); d[2] = bflo(v.y); d[3] = bfhi(v.y); d[4] = bflo(v.z); d[5] = bfhi(v.z); d[6] = bflo(v.w); d[7] = bfhi(v.w); }
            __syncthreads();
#pragma unroll 8
            for (int kk = 0; kk < 32; ++kk) {
                float av[4], bv[4];
#pragma unroll
                for (int i = 0; i < 4; ++i) av[i] = As[(ty + TY * i) * 33 + kk];
#pragma unroll
                for (int j = 0; j < 4; ++j) bv[j] = Bs[(tx + TX * j) * 33 + kk];
#pragma unroll
                for (int i = 0; i < 4; ++i)
#pragma unroll
                    for (int j = 0; j < 4; ++j) acc[i][j] += av[i] * bv[j];
            }
        }
#pragma unroll
        for (int i = 0; i < 4; ++i) epi(tm * BMn + ty + TY * i, tn * BNn, tx, acc[i]);
    }
    __syncthreads();
}

struct RefEpiIn {
    const Args* a; int l;
    __device__ __forceinline__ void operator()(int m, int cb, int tx, const float (&v)[4]) const {
        unsigned char* ws = a->ws;
        const bool smp = m >= MP;
        const int b = smp ? ((m - MP) >> 10) : (m >> 8), t = smp ? ((m - MP) & 1023) : (m & 255);
        if (cb < C_Q) {
            bf16* P = (bf16*)(ws + WS_PP) + (size_t)m * 256 + cb + tx;
#pragma unroll
            for (int j = 0; j < 4; ++j) P[16 * j] = (bf16)f2bf(v[j]);
        } else if (cb < C_V) {
            float o[4] = {v[0], v[1], v[2], v[3]};
            if (smp) {
                const float* rope = (const float*)(ws + WS_ROPE);
                const int pr = t >> 6, pc = t & 63;
                const float cr = rope[pr * 16 + tx], sr = rope[1024 + pr * 16 + tx], cc = rope[pc * 16 + tx], sn = rope[1024 + pc * 16 + tx];
                o[0] = v[0] * cr - v[1] * sr; o[1] = v[1] * cr + v[0] * sr;
                o[2] = v[2] * cc - v[3] * sn; o[3] = v[3] * cc + v[2] * sn;
            }
            if (cb < C_K) {
                bf16* Q = (bf16*)(ws + WS_Q) + (size_t)m * 512 + (cb - C_Q) + tx;
#pragma unroll
                for (int j = 0; j < 4; ++j) Q[16 * j] = (bf16)f2bf(o[j] * QSCALE);
            } else {
                const int col = (cb - C_K) + tx;
                bf16* Kd = smp ? (bf16*)(ws + WS_KS) + ((size_t)(b * LKS + PAST + t) * 512 + col) : (bf16*)(ws + WS_KP) + ((size_t)(b * LP + t) * 512 + col);
#pragma unroll
                for (int j = 0; j < 4; ++j) Kd[16 * j] = (bf16)f2bf(o[j]);
                if (!smp) { float* ok = a->out + OUT_K + ((size_t)(b * 2 + l) * 256 + t) * 512 + col;
#pragma unroll
                    for (int j = 0; j < 4; ++j) ok[16 * j] = o[j]; }
            }
        } else if (cb < C_U) {
#pragma unroll
            for (int j = 0; j < 4; ++j) {
                const int col = (cb - C_V) + tx + 16 * j, h = col >> 7, d = col & 127;
                if (smp) ((bf16*)(ws + WS_VTS))[((size_t)(b * 4 + h) * 128 + d) * LKS + PAST + perm16(t)] = (bf16)f2bf(v[j]);
                else { ((bf16*)(ws + WS_VTP))[((size_t)(b * 4 + h) * 128 + d) * LP + perm16(t)] = (bf16)f2bf(v[j]);
                       a->out[OUT_V + ((size_t)(b * 2 + l) * 256 + t) * 512 + col] = v[j]; }
            }
        } else {
            bf16* U = (cb < C_VG) ? (bf16*)(ws + WS_U) + (size_t)m * 256 + (cb - C_U) + tx : (bf16*)(ws + WS_VG) + (size_t)m * 256 + (cb - C_VG) + tx;
#pragma unroll
            for (int j = 0; j < 4; ++j) U[16 * j] = (bf16)f2bf(gelu_tanh(v[j]));
        }
    }
};
struct RefEpiRes {
    const Args* a; const Frame* Fp; int l; int gi; int first;
    __device__ __forceinline__ void operator()(int m, int cb, int tx, const float (&v)[4]) const {
        const float* src = xrow_ptr(*a, *Fp, first, m);
        const float* gate = (const float*)(a->ws + WS_MOD) + ((size_t)l * NCOND + cond_of_row(m)) * NMOD + gi * D;
        float* X = a->out + (size_t)m * D;
#pragma unroll
        for (int j = 0; j < 4; ++j) { const int n = cb + tx + 16 * j; X[n] = src[n] + gate[n] * v[j]; }
    }
};
struct RefEpiSwiglu {
    const Args* a;
    __device__ __forceinline__ void operator()(int m, int cb, int tx, const float (&v)[4]) const {
        bf16* ACT = (bf16*)(a->ws + WS_ACT) + (size_t)m * DFF + (cb >> 1) + tx;
        ACT[0] = (bf16)f2bf(silu_f(v[0]) * v[2]);
        ACT[64] = (bf16)f2bf(silu_f(v[1]) * v[3]);
    }
};

namespace pg8 {
#define PG8_LAS __attribute__((address_space(3)))
typedef unsigned short bf16_t;
typedef short bf16x8 __attribute__((ext_vector_type(8)));
typedef float f32x4 __attribute__((ext_vector_type(4)));
typedef unsigned u32x4 __attribute__((ext_vector_type(4)));
constexpr int BM = 256, BK = 64, HALF = 128, HTB = HALF * BK * 2  , STAGE_BYTES = 8 * HTB, NXCD = 8, WGM = 8;

__host__ __device__ __forceinline__ int lds_byte(int r, int c) { const int st = (r >> 4) * 2 + (c >> 5), rr = r & 15, cc = c & 31, ob = rr * 64 + cc * 2; return st * 1024 + (ob ^ (((ob >> 9) & 1) << 5)); }
__host__ __device__ __forceinline__ void stage_rc(int b, int& R, int& C) { const int st = b / 1024, sb = b % 1024, swz = sb ^ (((sb >> 9) & 1) << 5); R = (st >> 1) * 16 + swz / 64; C = (st & 1) * 32 + (swz % 64) / 2; }
__host__ __device__ __forceinline__ int perm32(int rho) { const int n = rho >> 4, i = rho & 15; return 8 * (i >> 2) + 4 * n + (i & 3); }

struct Unit { int pm, pn; };
struct Gemm { const bf16_t* A; const bf16_t* Bt; int M, N, K; };

struct StaticOrder {
    int nM, nN, nwg, G, c;
    __host__ __device__ void init(int M, int N, int G_, int c_) { nM = M / BM; nN = N / BM; nwg = nM * nN; G = G_; c = c_; }
    __host__ __device__ bool next(int i, Unit& u) const {
        const long L = (long)i * G + c; if (L >= nwg) return false;
        int wgid = (int)L; { const int q = nwg / NXCD, r = nwg % NXCD, xcd = wgid % NXCD, off = wgid / NXCD; wgid = (xcd < r ? xcd * (q + 1) : r * (q + 1) + (xcd - r) * q) + off; }
        const int nig = WGM * nN, gid = wgid / nig, fm = gid * WGM, gsz = (nM - fm) < WGM ? (nM - fm) : WGM;
        u.pm = fm + ((wgid % nig) % gsz); u.pn = (wgid % nig) / gsz; return true;
    }
    __device__ __forceinline__ void a_ready(const Unit&) const {}
    __device__ __forceinline__ void done(const Unit&) const {}
};
__device__ __forceinline__ unsigned cvt_pk_bf16(float lo, float hi) { unsigned r; asm volatile("v_cvt_pk_bf16_f32 %0, %1, %2" : "=v"(r) : "v"(lo), "v"(hi)); return r; }

__device__ __forceinline__ float fast_silu(float x) { return x * __builtin_amdgcn_rcpf(1.0f + __expf(-x)); }
__device__ __forceinline__ float fast_gelu_tanh(float x) {
    const float u = 0.7978845608028654f * (x + 0.044715f * x * x * x);
    const float t = 1.0f - 2.0f * __builtin_amdgcn_rcpf(__expf(2.0f * u) + 1.0f);
    return 0.5f * x * (1.0f + t);
}
typedef unsigned u32x2v __attribute__((ext_vector_type(2)));
struct EpiIn {
    static constexpr bool PERM = false, AFTER_DRAIN = false;
    unsigned char* ws; float* out; int l;
    __device__ __forceinline__ void operator()(const f32x4 (&acc)[2][2][4][2], const Unit& u, int wr, int wc, int fr, int fq) const {
        const bool smp = u.pm >= 16;
        const int b = smp ? ((u.pm - 16) >> 2) : u.pm;
        const int tb = (smp ? ((u.pm - 16) & 3) * 256 : 0) + wr * 64 + fr;
        const int rowb = u.pm * BM + wr * 64 + fr;
        const int pn = u.pn;
        if (pn == 0) {
            bf16_t* P = (bf16_t*)(ws + WS_PP) + (size_t)rowb * 256 + wc * 32 + 4 * fq;
#pragma unroll
            for (int ai = 0; ai < 2; ++ai)
#pragma unroll
                for (int m = 0; m < 4; ++m)
#pragma unroll
                    for (int bj = 0; bj < 2; ++bj)
#pragma unroll
                        for (int n = 0; n < 2; ++n) { const f32x4 v = acc[ai][bj][m][n];
                            *(u32x2v*)(P + (size_t)(ai * HALF + m * 16) * 256 + bj * HALF + n * 16) = (u32x2v){cvt_pk_bf16(v[0], v[1]), cvt_pk_bf16(v[2], v[3])}; }
        } else if (pn <= 4) {
            const bool isq = pn <= 2;
            const int colt = (isq ? (pn - 1) : (pn - 3)) * 256 + wc * 32 + 4 * fq;
            const float* rope = (const float*)(ws + WS_ROPE);
#pragma unroll
            for (int ai = 0; ai < 2; ++ai)
#pragma unroll
                for (int m = 0; m < 4; ++m) {
                    const int t = tb + ai * HALF + m * 16, row = rowb + ai * HALF + m * 16;
                    f32x4 cs = {1.f, 1.f, 1.f, 1.f}, sn = {0.f, 0.f, 0.f, 0.f};
                    if (smp) { const int pos = (wc & 1) ? (t & 63) : (t >> 6); cs = *(const f32x4*)(rope + pos * 16 + 4 * fq); sn = *(const f32x4*)(rope + 1024 + pos * 16 + 4 * fq); }
#pragma unroll
                    for (int bj = 0; bj < 2; ++bj) {
                        const f32x4 x1 = acc[ai][bj][m][0], x2 = acc[ai][bj][m][1];
                        f32x4 o1 = x1 * cs - x2 * sn, o2 = x2 * cs + x1 * sn;
                        const int col = colt + bj * HALF;
                        if (isq) {
                            o1 = o1 * QSCALE; o2 = o2 * QSCALE;
                            bf16_t* q = (bf16_t*)(ws + WS_Q) + (size_t)row * 512 + col;
                            *(u32x2v*)(q) = (u32x2v){cvt_pk_bf16(o1[0], o1[1]), cvt_pk_bf16(o1[2], o1[3])};
                            *(u32x2v*)(q + 16) = (u32x2v){cvt_pk_bf16(o2[0], o2[1]), cvt_pk_bf16(o2[2], o2[3])};
                        } else {
                            bf16_t* k = smp ? (bf16_t*)(ws + WS_KS) + ((size_t)(b * LKS + PAST + t) * 512 + col) : (bf16_t*)(ws + WS_KP) + ((size_t)(b * LP + t) * 512 + col);
                            *(u32x2v*)(k) = (u32x2v){cvt_pk_bf16(o1[0], o1[1]), cvt_pk_bf16(o1[2], o1[3])};
                            *(u32x2v*)(k + 16) = (u32x2v){cvt_pk_bf16(o2[0], o2[1]), cvt_pk_bf16(o2[2], o2[3])};
                            if (!smp) { float* ok = out + OUT_K + ((size_t)(b * 2 + l) * 256 + t) * 512 + col; *(f32x4*)ok = o1; *(f32x4*)(ok + 16) = o2; }
                        }
                    }
                }
        } else if (pn <= 6) {
            const int Lk = smp ? LKS : LP, koff = smp ? PAST : 0;
            bf16_t* vt = smp ? (bf16_t*)(ws + WS_VTS) : (bf16_t*)(ws + WS_VTP);
#pragma unroll
            for (int ai = 0; ai < 2; ++ai)
#pragma unroll
                for (int m = 0; m < 4; ++m) {
                    const int t = tb + ai * HALF + m * 16;
                    const int pt = koff + ((t & ~12) | ((t & 4) << 1) | ((t & 8) >> 1));
#pragma unroll
                    for (int bj = 0; bj < 2; ++bj) {
                        const int h = 2 * (pn - 5) + bj;
#pragma unroll
                        for (int n = 0; n < 2; ++n) {
                            const f32x4 v = acc[ai][bj][m][n];
                            const int d0 = wc * 32 + n * 16 + 4 * fq;
                            bf16_t* dst = vt + ((size_t)(b * 4 + h) * 128 + d0) * Lk + pt;
                            const unsigned w01 = cvt_pk_bf16(v[0], v[1]), w23 = cvt_pk_bf16(v[2], v[3]);
                            dst[0] = (bf16_t)(w01 & 0xffffu); dst[(size_t)Lk] = (bf16_t)(w01 >> 16); dst[(size_t)2 * Lk] = (bf16_t)(w23 & 0xffffu); dst[(size_t)3 * Lk] = (bf16_t)(w23 >> 16);
                            if (!smp) *(f32x4*)(out + OUT_V + ((size_t)(b * 2 + l) * 256 + t) * 512 + (pn - 5) * 256 + bj * HALF + d0) = v;
                        }
                    }
                }
        } else {
            bf16_t* U = (bf16_t*)(ws + (pn == 7 ? WS_U : WS_VG)) + (size_t)rowb * 256 + wc * 32 + 4 * fq;
#pragma unroll
            for (int ai = 0; ai < 2; ++ai)
#pragma unroll
                for (int m = 0; m < 4; ++m)
#pragma unroll
                    for (int bj = 0; bj < 2; ++bj)
#pragma unroll
                        for (int n = 0; n < 2; ++n) { const f32x4 v = acc[ai][bj][m][n];
                            *(u32x2v*)(U + (size_t)(ai * HALF + m * 16) * 256 + bj * HALF + n * 16) =
                                (u32x2v){cvt_pk_bf16(fast_gelu_tanh(v[0]), fast_gelu_tanh(v[1])), cvt_pk_bf16(fast_gelu_tanh(v[2]), fast_gelu_tanh(v[3]))}; }
        }
    }
};
struct EpiRes {
    static constexpr bool PERM = false, AFTER_DRAIN = false;
    const float* xp; const float* xs; float* X; const float* gate_l; int first;
    __device__ __forceinline__ void operator()(const f32x4 (&acc)[2][2][4][2], const Unit& u, int wr, int wc, int fr, int fq) const {
        const bool smp = u.pm >= 16;
        const int cb = smp ? ((u.pm - 16) >> 2) : 8;
        const int col0 = u.pn * BM + wc * 32 + 4 * fq;
        const float* gate = gate_l + (size_t)cb * NMOD + col0;
        f32x4 gv[2][2];
#pragma unroll
        for (int bj = 0; bj < 2; ++bj)
#pragma unroll
            for (int n = 0; n < 2; ++n) gv[bj][n] = *(const f32x4*)(gate + bj * HALF + n * 16);
        const int row0 = u.pm * BM + wr * 64 + fr;
        const float* sbase = first ? (smp ? xs + (size_t)(row0 - MP) * D : xp + (size_t)row0 * D) : X + (size_t)row0 * D;
        float* obase = X + (size_t)row0 * D;
#pragma unroll
        for (int ai = 0; ai < 2; ++ai)
#pragma unroll
            for (int m = 0; m < 4; ++m) {
                const size_t ro = (size_t)(ai * HALF + m * 16) * D + col0;
#pragma unroll
                for (int bj = 0; bj < 2; ++bj)
#pragma unroll
                    for (int n = 0; n < 2; ++n) { const f32x4 sv = *(const f32x4*)(sbase + ro + bj * HALF + n * 16); *(f32x4*)(obase + ro + bj * HALF + n * 16) = sv + gv[bj][n] * acc[ai][bj][m][n]; }
                if (m & 1) asm volatile("" ::: "memory");
            }
    }
};
struct EpiSwiglu {
    static constexpr bool PERM = true, AFTER_DRAIN = false;
    bf16_t* ACT;
    __device__ __forceinline__ void operator()(const f32x4 (&acc)[2][2][4][2], const Unit& u, int wr, int wc, int fr, int fq) const {
        bf16_t* base = ACT + (size_t)(u.pm * BM + wr * 64 + fr) * DFF + u.pn * HALF + wc * 32 + 8 * fq;
#pragma unroll
        for (int ai = 0; ai < 2; ++ai)
#pragma unroll
            for (int m = 0; m < 4; ++m) {
                const f32x4 g0 = acc[ai][0][m][0], g1 = acc[ai][0][m][1], u0 = acc[ai][1][m][0], u1 = acc[ai][1][m][1];
                u32x4 w;
                w.x = cvt_pk_bf16(fast_silu(g0[0]) * u0[0], fast_silu(g0[1]) * u0[1]); w.y = cvt_pk_bf16(fast_silu(g0[2]) * u0[2], fast_silu(g0[3]) * u0[3]);
                w.z = cvt_pk_bf16(fast_silu(g1[0]) * u1[0], fast_silu(g1[1]) * u1[1]); w.w = cvt_pk_bf16(fast_silu(g1[2]) * u1[2], fast_silu(g1[3]) * u1[3]);
                *(u32x4*)(base + (size_t)(ai * HALF + m * 16) * DFF) = w;
            }
    }
};

template <class Epi, class Sched, bool ALIGN_EPI = false, bool SP2 = false>
__device__ __forceinline__ void gemm_phase(PG8_LAS unsigned char* lds, const Gemm g, const Sched& S, const Epi& E) {
    const int tid = threadIdx.x, wid = __builtin_amdgcn_readfirstlane(tid >> 6), lane = tid & 63, wr = wid >> 2, wc = wid & 3, fr = lane & 15, fq = lane >> 4;
    const int K = g.K, nt = K / BK;
    unsigned voffA[2], voffB[2];
#pragma unroll
    for (int i = 0; i < 2; ++i) { int R, C; stage_rc(tid * 16 + i * 8192, R, C); const int Rb = Epi::PERM ? ((R & ~31) + perm32(R & 31)) : R;
        voffA[i] = (unsigned)(R * K + C) * 2u; voffB[i] = (unsigned)(Rb * K + C) * 2u; }
    const size_t kstep = (size_t)(BK * 2);
    const size_t hstep = (size_t)HALF * K * 2;
    const size_t tstep = 2 * hstep;
    const unsigned ldsw = (unsigned)wid * 1024u;
    const int aoff = lds_byte(wr * 64 + fr, fq * 8), boff = lds_byte(wc * 32 + fr, fq * 8);
#define PG8_SA(b, h) (((b) * 2 + (h)) * HTB)
#define PG8_SB(b, h) ((4 + (b) * 2 + (h)) * HTB)
#define PG8_STAGE(bufoff, gbase, voff) do { _Pragma("unroll") for (int _i = 0; _i < 2; ++_i) \
        __builtin_amdgcn_global_load_lds((const unsigned*)((const char*)(gbase) + (voff)[_i]), (PG8_LAS unsigned*)(lds + (bufoff) + ldsw + _i * 8192), 16, 0, 0); } while (0)
#define PG8_LDA(dst, b, h) do { _Pragma("unroll") for (int m = 0; m < 4; ++m) _Pragma("unroll") for (int k = 0; k < 2; ++k) dst[m][k] = *(const PG8_LAS bf16x8*)(lds + PG8_SA(b, h) + aoff + m * 2048 + k * 1024); } while (0)
#define PG8_LDB(dst, b, h) do { _Pragma("unroll") for (int n = 0; n < 2; ++n) _Pragma("unroll") for (int k = 0; k < 2; ++k) dst[n][k] = *(const PG8_LAS bf16x8*)(lds + PG8_SB(b, h) + boff + n * 2048 + k * 1024); } while (0)
#define PG8_MMA(ai, bj, At, Bt) do { __builtin_amdgcn_s_setprio(1); _Pragma("unroll") for (int m = 0; m < 4; ++m) _Pragma("unroll") for (int n = 0; n < 2; ++n) _Pragma("unroll") for (int k = 0; k < 2; ++k) \
        acc[ai][bj][m][n] = __builtin_amdgcn_mfma_f32_16x16x32_bf16(Bt[n][k], At[m][k], acc[ai][bj][m][n], 0, 0, 0); __builtin_amdgcn_s_setprio(0); } while (0)
#define PG8_WAIT_V(n) asm volatile("s_waitcnt vmcnt(" #n ")" ::: "memory")
#define PG8_WAIT_L(n) asm volatile("s_waitcnt lgkmcnt(" #n ")" ::: "memory")
#define PG8_BAR __builtin_amdgcn_s_barrier()
#define PG8_SCHED __builtin_amdgcn_sched_barrier(0)
    Unit cur, nxt; int ui = 0;
    if (!S.next(0, cur)) return;
    f32x4 acc[2][2][4][2];
#pragma unroll
    for (int a = 0; a < 2; ++a)
#pragma unroll
        for (int b = 0; b < 2; ++b)
#pragma unroll
            for (int m = 0; m < 4; ++m)
#pragma unroll
                for (int n = 0; n < 2; ++n) acc[a][b][m][n] = (f32x4){0.f, 0.f, 0.f, 0.f};
    bf16x8 At[4][2], B0[2][2], B1[2][2];
    const char* cA = (const char*)g.A + (size_t)cur.pm * tstep; const char* cB = (const char*)g.Bt + (size_t)cur.pn * tstep;
    S.a_ready(cur);
    if constexpr (SP2) {
        PG8_STAGE(PG8_SB(0, 0), cB, voffB); PG8_STAGE(PG8_SB(0, 1), cB + hstep, voffB); PG8_STAGE(PG8_SA(0, 0), cA, voffA); PG8_STAGE(PG8_SA(0, 1), cA + hstep, voffA);
        if (wr == 1) PG8_BAR;
        PG8_WAIT_V(2); PG8_BAR;
        PG8_STAGE(PG8_SB(1, 0), cB + kstep, voffB); PG8_STAGE(PG8_SA(1, 0), cA + kstep, voffA); PG8_STAGE(PG8_SB(1, 1), cB + hstep + kstep, voffB);
        PG8_WAIT_V(6); PG8_BAR;
    } else {
        PG8_STAGE(PG8_SB(0, 0), cB, voffB); PG8_STAGE(PG8_SA(0, 0), cA, voffA); PG8_STAGE(PG8_SB(0, 1), cB + hstep, voffB); PG8_STAGE(PG8_SA(0, 1), cA + hstep, voffA);
        if (wr == 1) PG8_BAR;
        PG8_WAIT_V(4); PG8_BAR;
        PG8_STAGE(PG8_SB(1, 0), cB + kstep, voffB); PG8_STAGE(PG8_SA(1, 0), cA + kstep, voffA); PG8_STAGE(PG8_SB(1, 1), cB + hstep + kstep, voffB);
        PG8_WAIT_V(6); PG8_BAR;
    }
    for (;;) {
        const bool has_next = S.next(ui + 1, nxt);
        const char* nA = has_next ? (const char*)g.A + (size_t)nxt.pm * tstep : cA; const char* nB = has_next ? (const char*)g.Bt + (size_t)nxt.pn * tstep : cB;
        for (int t = 0; t < nt; t += 2) {
            const bool last = (t == nt - 2);
            const char* a1 = cA + (size_t)(t + 1) * kstep;
            const char* a2 = last ? nA : cA + (size_t)(t + 2) * kstep; const char* b2 = last ? nB : cB + (size_t)(t + 2) * kstep;
            const char* a3 = a2 + kstep; const char* b3 = b2 + kstep;
            if (last && has_next) S.a_ready(nxt);
            if constexpr (SP2) {
            PG8_LDB(B0, 0, 0); PG8_LDB(B1, 0, 1); PG8_SCHED; PG8_LDA(At, 0, 0); PG8_STAGE(PG8_SA(1, 1), a1 + hstep, voffA);
            PG8_WAIT_V(8); PG8_WAIT_L(0); PG8_BAR; PG8_MMA(0, 0, At, B0); PG8_MMA(0, 1, At, B1); PG8_BAR; PG8_SCHED;
            PG8_LDA(At, 0, 1); PG8_STAGE(PG8_SB(0, 0), b2, voffB); PG8_STAGE(PG8_SB(0, 1), b2 + hstep, voffB); PG8_STAGE(PG8_SA(0, 0), a2, voffA);
            PG8_WAIT_V(8); PG8_WAIT_L(0); PG8_BAR; PG8_MMA(1, 0, At, B0); PG8_MMA(1, 1, At, B1); PG8_BAR; PG8_SCHED;
            PG8_LDB(B0, 1, 0); PG8_LDB(B1, 1, 1); PG8_SCHED; PG8_LDA(At, 1, 0); PG8_STAGE(PG8_SA(0, 1), a2 + hstep, voffA);
            PG8_WAIT_V(8); PG8_WAIT_L(0); PG8_BAR; PG8_MMA(0, 0, At, B0); PG8_MMA(0, 1, At, B1); PG8_BAR; PG8_SCHED;
            PG8_LDA(At, 1, 1); PG8_STAGE(PG8_SB(1, 0), b3, voffB); PG8_STAGE(PG8_SB(1, 1), b3 + hstep, voffB); PG8_STAGE(PG8_SA(1, 0), a3, voffA);
            PG8_WAIT_V(8); PG8_WAIT_L(0); PG8_BAR; PG8_MMA(1, 0, At, B0); PG8_MMA(1, 1, At, B1); PG8_BAR; PG8_SCHED;
            } else {
            PG8_LDB(B0, 0, 0); PG8_SCHED; PG8_LDA(At, 0, 0); PG8_STAGE(PG8_SA(1, 1), a1 + hstep, voffA);
            PG8_WAIT_L(8); PG8_BAR; PG8_WAIT_L(0); PG8_MMA(0, 0, At, B0); PG8_BAR; PG8_SCHED;
            PG8_LDB(B1, 0, 1); PG8_STAGE(PG8_SB(0, 0), b2, voffB);
            PG8_BAR; PG8_WAIT_L(0); PG8_MMA(0, 1, At, B1); PG8_BAR;
            PG8_LDA(At, 0, 1); PG8_STAGE(PG8_SA(0, 0), a2, voffA);
            PG8_BAR; PG8_WAIT_L(0); PG8_MMA(1, 0, At, B0); PG8_BAR; PG8_SCHED;
            PG8_STAGE(PG8_SB(0, 1), b2 + hstep, voffB);
            PG8_WAIT_V(6); PG8_BAR; PG8_MMA(1, 1, At, B1); PG8_BAR;
            PG8_LDB(B0, 1, 0); PG8_SCHED; PG8_LDA(At, 1, 0); PG8_STAGE(PG8_SA(0, 1), a2 + hstep, voffA);
            PG8_WAIT_L(8); PG8_BAR; PG8_WAIT_L(0); PG8_MMA(0, 0, At, B0); PG8_BAR; PG8_SCHED;
            PG8_LDB(B1, 1, 1); PG8_STAGE(PG8_SB(1, 0), b3, voffB);
            PG8_BAR; PG8_WAIT_L(0); PG8_MMA(0, 1, At, B1); PG8_BAR;
            PG8_LDA(At, 1, 1); PG8_STAGE(PG8_SA(1, 0), a3, voffA);
            PG8_BAR; PG8_WAIT_L(0); PG8_MMA(1, 0, At, B0); PG8_BAR; PG8_SCHED;
            PG8_STAGE(PG8_SB(1, 1), b3 + hstep, voffB);
            PG8_WAIT_V(6); PG8_BAR; PG8_MMA(1, 1, At, B1); PG8_BAR;
            }
        }
        if constexpr (ALIGN_EPI) { if (wr == 0) PG8_BAR; }
        if constexpr (!Epi::AFTER_DRAIN) { E(acc, cur, wr, wc, fr, fq); S.done(cur); }
        if (!has_next) break;
#pragma unroll
        for (int a = 0; a < 2; ++a)
#pragma unroll
            for (int b = 0; b < 2; ++b)
#pragma unroll
                for (int m = 0; m < 4; ++m)
#pragma unroll
                    for (int n = 0; n < 2; ++n) acc[a][b][m][n] = (f32x4){0.f, 0.f, 0.f, 0.f};
        cur = nxt; cA = nA; cB = nB; ++ui;
        if constexpr (ALIGN_EPI) { if (wr == 1) PG8_BAR; }
    }
    PG8_WAIT_V(0);
    if constexpr (!ALIGN_EPI) { if (wr == 0) PG8_BAR; }
    PG8_BAR;
    if constexpr (Epi::AFTER_DRAIN) { E.fused(acc, cur, wr, wc, fr, fq, lds, wid, lane); S.done(cur); }
#undef PG8_SA
#undef PG8_SB
#undef PG8_STAGE
#undef PG8_LDA
#undef PG8_LDB
#undef PG8_MMA
#undef PG8_WAIT_V
#undef PG8_WAIT_L
#undef PG8_BAR
#undef PG8_SCHED
}
}

namespace fa {
typedef short bf16x8 __attribute__((ext_vector_type(8)));
typedef float f32x16 __attribute__((ext_vector_type(16)));
constexpr int KROW = 272, VROW = 144, KT_BYTES = 64 * KROW, VT_BYTES = 128 * VROW, STAGE = KT_BYTES + VT_BYTES;
static_assert(2 * STAGE <= PHASE_LDS && 4 * 128 * 32 * 4 <= 2 * STAGE, "attention LDS map");
__device__ __forceinline__ unsigned cvt_pk(float lo, float hi) { unsigned r; asm volatile("v_cvt_pk_bf16_f32 %0, %1, %2" : "=v"(r) : "v"(lo), "v"(hi)); return r; }
__device__ __forceinline__ bf16x8 pack8(const f32x16& p, int b) {
    u32x4 w; w.x = cvt_pk(p[b + 0], p[b + 1]); w.y = cvt_pk(p[b + 2], p[b + 3]); w.z = cvt_pk(p[b + 4], p[b + 5]); w.w = cvt_pk(p[b + 6], p[b + 7]);
    return __builtin_bit_cast(bf16x8, w);
}
__device__ __forceinline__ void attn_unit(LAS unsigned char* lds, const bf16* Qg, const bf16* Kg, const bf16* Vg, const int Lk, bf16* MIXg, const float* subg, const float lam, const float post) {
    const int tid = threadIdx.x, lane = tid & 63, wid = __builtin_amdgcn_readfirstlane(tid >> 6), sm = wid & 1, qblk = wid >> 1, l31 = lane & 31, hh = lane >> 5;
    bf16x8 qf[4];
    { const bf16* qrow = Qg + (size_t)(qblk * 32 + l31) * 512 + sm * 64 + hh * 8;
#pragma unroll
      for (int ks = 0; ks < 4; ++ks) qf[ks] = *(const bf16x8*)(qrow + 16 * ks); }
    f32x16 o[4];
#pragma unroll
    for (int db = 0; db < 4; ++db)
#pragma unroll
        for (int r = 0; r < 16; ++r) o[db][r] = 0.f;
    float m_run = -1e30f, l_run = 0.f;
    const int nt = Lk >> 6;
    const int kr = tid >> 3, kc = tid & 7, vr = tid >> 2, vc = tid & 3;
    const bf16* kg = Kg + (size_t)kr * 512 + kc * 8;
    const bf16* vg = Vg + (size_t)vr * Lk + vc * 8;
    const int kw = kr * KROW + kc * 16, vw = KT_BYTES + vr * VROW + vc * 16;
    u32x4 sk0 = *(const u32x4*)(kg), sk1 = *(const u32x4*)(kg + 64), sv0 = *(const u32x4*)(vg), sv1 = *(const u32x4*)(vg + 32);
    *(LAS u32x4*)(lds + kw) = sk0; *(LAS u32x4*)(lds + kw + 128) = sk1; *(LAS u32x4*)(lds + vw) = sv0; *(LAS u32x4*)(lds + vw + 64) = sv1;
    __syncthreads();
    const int ka = l31 * KROW + (sm * 64 + hh * 8) * 2, va = KT_BYTES + l31 * VROW + hh * 16;
#pragma unroll 1
    for (int i = 0; i < nt; ++i) {
        LAS unsigned char* cur = lds + (i & 1) * STAGE;
        const bool more = (i + 1 < nt);
        if (more) { const bf16* k2 = kg + (size_t)(i + 1) * 64 * 512; const bf16* v2 = vg + (i + 1) * 64;
            sk0 = *(const u32x4*)(k2); sk1 = *(const u32x4*)(k2 + 64); sv0 = *(const u32x4*)(v2); sv1 = *(const u32x4*)(v2 + 32); }
        f32x16 s0, s1;
#pragma unroll
        for (int r = 0; r < 16; ++r) { s0[r] = 0.f; s1[r] = 0.f; }
#pragma unroll
        for (int ks = 0; ks < 4; ++ks) {
            const bf16x8 a0 = *(const LAS bf16x8*)(cur + ka + ks * 32), a1 = *(const LAS bf16x8*)(cur + ka + 32 * KROW + ks * 32);
            s0 = __builtin_amdgcn_mfma_f32_32x32x16_bf16(a0, qf[ks], s0, 0, 0, 0);
            s1 = __builtin_amdgcn_mfma_f32_32x32x16_bf16(a1, qf[ks], s1, 0, 0, 0);
        }
        float mx = fmaxf(s0[0], s1[0]);
#pragma unroll
        for (int r = 1; r < 16; ++r) mx = fmaxf(mx, fmaxf(s0[r], s1[r]));
        mx = fmaxf(mx, __shfl_xor(mx, 32));
        if (__any(mx > m_run)) {
            const float mn = fmaxf(m_run, mx), alpha = __builtin_amdgcn_exp2f(m_run - mn);
#pragma unroll
            for (int db = 0; db < 4; ++db)
#pragma unroll
                for (int r = 0; r < 16; ++r) o[db][r] *= alpha;
            l_run *= alpha; m_run = mn;
        }
        float ps = 0.f;
#pragma unroll
        for (int r = 0; r < 16; ++r) { s0[r] = __builtin_amdgcn_exp2f(s0[r] - m_run); s1[r] = __builtin_amdgcn_exp2f(s1[r] - m_run); ps += s0[r] + s1[r]; }
        l_run += ps;
        bf16x8 pf[4];
        pf[0] = pack8(s0, 0); pf[1] = pack8(s0, 8); pf[2] = pack8(s1, 0); pf[3] = pack8(s1, 8);
#pragma unroll
        for (int db = 0; db < 4; ++db)
#pragma unroll
            for (int st = 0; st < 4; ++st) {
                const bf16x8 a = *(const LAS bf16x8*)(cur + va + db * 32 * VROW + st * 32);
                o[db] = __builtin_amdgcn_mfma_f32_32x32x16_bf16(a, pf[st], o[db], 0, 0, 0);
            }
        if (more) { LAS unsigned char* nx = lds + ((i + 1) & 1) * STAGE;
            *(LAS u32x4*)(nx + kw) = sk0; *(LAS u32x4*)(nx + kw + 128) = sk1; *(LAS u32x4*)(nx + vw) = sv0; *(LAS u32x4*)(nx + vw + 64) = sv1; }
        __syncthreads();
    }
    const float ltot = l_run + __shfl_xor(l_run, 32);
    LAS float* X = (LAS float*)lds + qblk * 128 * 32;
    if (sm == 1) {
        const float sc = lam / ltot;
#pragma unroll
        for (int db = 0; db < 4; ++db)
#pragma unroll
            for (int r = 0; r < 16; ++r) X[(32 * db + (r & 3) + 8 * (r >> 2) + 4 * hh) * 32 + l31] = o[db][r] * sc;
    }
    __syncthreads();
    if (sm == 0) {
        const float sc = 1.0f / ltot; float ss = 0.f;
#pragma unroll
        for (int db = 0; db < 4; ++db)
#pragma unroll
            for (int r = 0; r < 16; ++r) { const float v = o[db][r] * sc - X[(32 * db + (r & 3) + 8 * (r >> 2) + 4 * hh) * 32 + l31]; o[db][r] = v; ss += v * v; }
        ss += __shfl_xor(ss, 32);
        const float rs = post / sqrtf(ss * (1.0f / 128.0f) + EPS);
        bf16* orow = MIXg + (size_t)(qblk * 32 + l31) * D + 4 * hh;
#pragma unroll
        for (int db = 0; db < 4; ++db)
#pragma unroll
            for (int g4 = 0; g4 < 4; ++g4) {
                const int d = 32 * db + 8 * g4;
                const f32x4 gv = *(const f32x4*)(subg + d + 4 * hh);
                const unsigned w0 = cvt_pk(o[db][4 * g4 + 0] * rs * gv.x, o[db][4 * g4 + 1] * rs * gv.y), w1 = cvt_pk(o[db][4 * g4 + 2] * rs * gv.z, o[db][4 * g4 + 3] * rs * gv.w);
                *(u32x2*)(orow + d) = (u32x2){w0, w1};
            }
    }
    __syncthreads();
}
}
__device__ __forceinline__ void attn_phase(const Args& a, Frame& F, int l) {
    const int G = gridDim.x, c = blockIdx.x;
    const int vcu = (G % 8 == 0) ? (c % 8) * (G / 8) + c / 8 : c;
    const float lam = ((const float*)(a.ws + WS_LAM))[l];
    const float post = 1.0f - ((l == 0) ? 0.2f : (float)(0.8 - 0.6 * 0.7408182206817179));
    const float* subg = inp(F, 16) + l * 128;
    const bf16* Q = (const bf16*)(a.ws + WS_Q); bf16* MIX = (bf16*)(a.ws + WS_MIX);
#pragma unroll 1
    for (int u = vcu; u < 384; u += G) {
        if (u < 256) {
            const int bh = u >> 3, qb = u & 7, b = bh >> 2, h = bh & 3, m0 = MP + b * LS + qb * 128;
            fa::attn_unit(F.lds, Q + (size_t)m0 * 512 + h * 128, (const bf16*)(a.ws + WS_KS) + (size_t)b * LKS * 512 + h * 128, (const bf16*)(a.ws + WS_VTS) + (size_t)(b * 4 + h) * 128 * LKS, LKS,
                          MIX + (size_t)m0 * D + 256 + h * 128, subg, lam, post);
        } else {
            const int v = u - 256, bh = v >> 1, qb = v & 1, b = bh >> 2, h = bh & 3, m0 = b * LP + qb * 128;
            fa::attn_unit(F.lds, Q + (size_t)m0 * 512 + h * 128, (const bf16*)(a.ws + WS_KP) + (size_t)b * LP * 512 + h * 128, (const bf16*)(a.ws + WS_VTP) + (size_t)(b * 4 + h) * 128 * LP, LP,
                          MIX + (size_t)m0 * D + 256 + h * 128, subg, lam, post);
        }
    }
}

__device__ __forceinline__ void attn_ref(const Args& a, Frame& F, int l) {
    LAS float* wq = (LAS float*)F.lds + F.wave * (128 + 3 * LKS);
    LAS float* ws1 = wq + 128;
    LAS float* ws2 = ws1 + LKS;
    LAS float* wp = ws2 + LKS;
    const bf16* Q = (const bf16*)(a.ws + WS_Q);
    bf16* MIX = (bf16*)(a.ws + WS_MIX);
    const float lam = ((const float*)(a.ws + WS_LAM))[l];
    const float lam_init = (l == 0) ? 0.2f : (float)(0.8 - 0.6 * 0.7408182206817179);
    const float* subg = inp(F, 16) + l * 128;
    const int gw = blockIdx.x * NWAVES + F.wave, NGW = gridDim.x * NWAVES;
#pragma unroll 1
    for (int it = gw; it < M * 4; it += NGW) {
        const int m = it >> 2, h = it & 3;
        const bool smp = m >= MP;
        const int b = smp ? ((m - MP) >> 10) : (m >> 8);
        const int Lk = smp ? LKS : LP, nk = Lk >> 6;
        const bf16* Kb = smp ? (const bf16*)(a.ws + WS_KS) + (size_t)b * LKS * 512 + h * 128 : (const bf16*)(a.ws + WS_KP) + (size_t)b * LP * 512 + h * 128;
        const bf16* Vb = smp ? (const bf16*)(a.ws + WS_VTS) + (size_t)(b * 4 + h) * 128 * LKS : (const bf16*)(a.ws + WS_VTP) + (size_t)(b * 4 + h) * 128 * LP;
        wq[F.lane] = bf2f(Q[(size_t)m * 512 + h * 128 + F.lane]); wq[64 + F.lane] = bf2f(Q[(size_t)m * 512 + h * 128 + 64 + F.lane]);
        asm volatile("s_waitcnt lgkmcnt(0)" ::: "memory");
        float m1 = -1e30f, m2 = -1e30f;
#pragma unroll 1
        for (int kk = 0; kk < nk; ++kk) {
            const u32x4* kr = (const u32x4*)(Kb + (size_t)(kk * 64 + F.lane) * 512);
            float d1 = 0.f, d2 = 0.f;
#pragma unroll
            for (int c = 0; c < 8; ++c) {
                const u32x4 k1 = kr[c], k2 = kr[8 + c];
                const f32x4 qa = *(const LAS f32x4*)(wq + 8 * c), qb = *(const LAS f32x4*)(wq + 8 * c + 4);
                const f32x4 qc = *(const LAS f32x4*)(wq + 64 + 8 * c), qd = *(const LAS f32x4*)(wq + 64 + 8 * c + 4);
                d1 += qa.x * bflo(k1.x) + qa.y * bfhi(k1.x) + qa.z * bflo(k1.y) + qa.w * bfhi(k1.y) + qb.x * bflo(k1.z) + qb.y * bfhi(k1.z) + qb.z * bflo(k1.w) + qb.w * bfhi(k1.w);
                d2 += qc.x * bflo(k2.x) + qc.y * bfhi(k2.x) + qc.z * bflo(k2.y) + qc.w * bfhi(k2.y) + qd.x * bflo(k2.z) + qd.y * bfhi(k2.z) + qd.z * bflo(k2.w) + qd.w * bfhi(k2.w);
            }
            ws1[kk * 64 + F.lane] = d1; ws2[kk * 64 + F.lane] = d2;
            m1 = fmaxf(m1, d1); m2 = fmaxf(m2, d2);
        }
        m1 = wave_max(m1); m2 = wave_max(m2);
        asm volatile("s_waitcnt lgkmcnt(0)" ::: "memory");
        float l1 = 0.f, l2 = 0.f;
#pragma unroll 1
        for (int kk = 0; kk < nk; ++kk) {
            const float e1 = exp2f(ws1[kk * 64 + F.lane] - m1), e2 = exp2f(ws2[kk * 64 + F.lane] - m2);
            ws1[kk * 64 + F.lane] = e1; ws2[kk * 64 + F.lane] = e2; l1 += e1; l2 += e2;
        }
        l1 = wave_sum(l1); l2 = wave_sum(l2);
        const float i1 = 1.0f / l1, i2 = lam / l2;
        asm volatile("s_waitcnt lgkmcnt(0)" ::: "memory");
#pragma unroll 1
        for (int kk = 0; kk < nk; ++kk) wp[perm16(kk * 64 + F.lane)] = ws1[kk * 64 + F.lane] * i1 - ws2[kk * 64 + F.lane] * i2;
        asm volatile("s_waitcnt lgkmcnt(0)" ::: "memory");
        float o0 = 0.f, o1 = 0.f;
        const bf16* v0 = Vb + (size_t)F.lane * Lk; const bf16* v1 = Vb + (size_t)(64 + F.lane) * Lk;
#pragma unroll 2
        for (int p = 0; p < Lk; p += 8) {
            const u32x4 a0 = *(const u32x4*)(v0 + p), a1 = *(const u32x4*)(v1 + p);
            const f32x4 pa = *(const LAS f32x4*)(wp + p), pb = *(const LAS f32x4*)(wp + p + 4);
            o0 += pa.x * bflo(a0.x) + pa.y * bfhi(a0.x) + pa.z * bflo(a0.y) + pa.w * bfhi(a0.y) + pb.x * bflo(a0.z) + pb.y * bfhi(a0.z) + pb.z * bflo(a0.w) + pb.w * bfhi(a0.w);
            o1 += pa.x * bflo(a1.x) + pa.y * bfhi(a1.x) + pa.z * bflo(a1.y) + pa.w * bfhi(a1.y) + pb.x * bflo(a1.z) + pb.y * bfhi(a1.z) + pb.z * bflo(a1.w) + pb.w * bfhi(a1.w);
        }
        const float ss = wave_sum(o0 * o0 + o1 * o1);
        const float r = (1.0f / sqrtf(ss * (1.0f / 128.0f) + EPS)) * (1.0f - lam_init);
        MIX[(size_t)m * D + 256 + h * 128 + F.lane] = (bf16)f2bf(o0 * r * subg[F.lane]);
        MIX[(size_t)m * D + 256 + h * 128 + 64 + F.lane] = (bf16)f2bf(o1 * r * subg[64 + F.lane]);
        asm volatile("s_waitcnt lgkmcnt(0)" ::: "memory");
    }
}
__device__ __forceinline__ void pool_phase(const Args& a, Frame& F, int l) {
    LAS float* P = (LAS float*)F.lds;
    LAS float* Qp = P + 48 * 256;
    LAS float* Wl = Qp + 32 * 256;
    const bf16* PP = (const bf16*)(a.ws + WS_PP);
    bf16* MIX = (bf16*)(a.ws + WS_MIX);
    const float* wpool = inp(F, 10) + (size_t)l * 4 * 64 * 64; const float* pscale = inp(F, 11) + l * 256;
    bool have = false;
#pragma unroll 1
    for (int unit = blockIdx.x; unit < M / 32; unit += gridDim.x) {
        const int m0 = unit * 32;
        const bool smp = m0 >= MP;
        const int L = smp ? LS : LP;
        const int t0 = smp ? ((m0 - MP) & 1023) : (m0 & 255);
        const int mseq = m0 - t0;
        __syncthreads();
        if (!have) { for (int i = F.tid; i < 4 * 64 * 64 / 4; i += NTHREADS) *(LAS f32x4*)(Wl + 4 * i) = *(const f32x4*)(wpool + 4 * i); have = true; }
#pragma unroll 1
        for (int i = F.tid; i < 48 * 64; i += NTHREADS) {
            const int r = i >> 6, c4 = (i & 63) * 4, t = t0 - 8 + r;
            f32x4 v = {0.f, 0.f, 0.f, 0.f};
            if (t >= 0 && t < L) { const u32x2 w = *(const u32x2*)(PP + (size_t)(mseq + t) * 256 + c4); v = (f32x4){bflo(w.x), bfhi(w.x), bflo(w.y), bfhi(w.y)}; }
            *(LAS f32x4*)(P + r * 256 + c4) = v;
        }
        __syncthreads();
#pragma unroll 1
        for (int i = F.tid; i < 32 * 256; i += NTHREADS) {
            const int tt = i >> 8, c = i & 255, g = c >> 6, hw = 1 << g;
            const int t = t0 + tt;
            int lo = t - hw; if (lo < 0) lo = 0;
            int hi = t + hw; if (hi > L) hi = L;
            float s = 0.f;
#pragma unroll 1
            for (int u = lo; u < hi; ++u) s += P[(u - t0 + 8) * 256 + c];
            Qp[tt * 256 + c] = s / (float)(hi - lo) - P[(tt + 8) * 256 + c];
        }
        __syncthreads();
        {
            const int d = F.tid & 63, g = (F.tid >> 6) & 3, half = F.tid >> 8;
            const float ps = pscale[g * 64 + d];
            const LAS float* wg = Wl + g * 4096 + d;
#pragma unroll 1
            for (int tt = half * 16; tt < half * 16 + 16; ++tt) {
                float acc = 0.f;
#pragma unroll 4
                for (int c = 0; c < 64; c += 4) { const f32x4 q = *(const LAS f32x4*)(Qp + tt * 256 + g * 64 + c);
                    acc += q.x * wg[(c + 0) * 64] + q.y * wg[(c + 1) * 64] + q.z * wg[(c + 2) * 64] + q.w * wg[(c + 3) * 64]; }
                MIX[(size_t)(m0 + tt) * D + g * 64 + d] = (bf16)f2bf(acc * ps);
            }
        }
    }
    __syncthreads();
}
__device__ __forceinline__ void sgu_ref(const Args& a, Frame& F, int l) {
    LAS float* vn = (LAS float*)F.lds;
    const bf16* VG = (const bf16*)(a.ws + WS_VG); const bf16* U = (const bf16*)(a.ws + WS_U);
    bf16* MIX = (bf16*)(a.ws + WS_MIX);
    const float* gn = inp(F, 17) + l * 256; const float* wsg = inp(F, 18) + (size_t)l * 4 * 128 * 128; const float* bsg = inp(F, 19) + l * 4 * 128;
    for (int unit = blockIdx.x; unit < M / 128; unit += gridDim.x) {
        const int m0 = unit * 128;
        __syncthreads();
        for (int q = F.wave; q < 128; q += NWAVES) {
            const u32x2 w = *(const u32x2*)(VG + (size_t)(m0 + q) * 256 + 4 * F.lane);
            const float x0 = bflo(w.x), x1 = bfhi(w.x), x2 = bflo(w.y), x3 = bfhi(w.y);
            const float mean = wave_sum((x0 + x1) + (x2 + x3)) * (1.0f / 256.0f);
            const float d0 = x0 - mean, d1 = x1 - mean, d2 = x2 - mean, d3 = x3 - mean;
            const float var = wave_sum((d0 * d0 + d1 * d1) + (d2 * d2 + d3 * d3)) * (1.0f / 256.0f);
            const float r = 1.0f / sqrtf(var + EPS);
            const f32x4 g4 = *(const f32x4*)(gn + 4 * F.lane);
            *(LAS f32x4*)(vn + q * 256 + 4 * F.lane) = (f32x4){d0 * r * g4.x, d1 * r * g4.y, d2 * r * g4.z, d3 * r * g4.w};
        }
        __syncthreads();
        const int c = F.tid & 255, ph = F.tid >> 8, g = c >> 6;
        for (int p = ph * 64; p < ph * 64 + 64; ++p) {
            const float* wr = wsg + ((size_t)g * 128 + p) * 128;
            float acc = bsg[g * 128 + p];
#pragma unroll 8
            for (int q = 0; q < 128; ++q) acc += wr[q] * vn[q * 256 + c];
            const float u = bf2f(U[(size_t)(m0 + p) * 256 + c]);
            MIX[(size_t)(m0 + p) * D + 768 + c] = (bf16)f2bf(u * acc);
        }
    }
    __syncthreads();
}
__device__ __forceinline__ void final_phase(const Args& a, Frame& F) {
    const float* g = inp(F, 24);
    const int gw = blockIdx.x * NWAVES + F.wave, NGW = gridDim.x * NWAVES;
    for (int m = gw; m < M; m += NGW) {
        f32x4* xr = (f32x4*)(a.out + (size_t)m * D) + F.lane;
        f32x4 v[4]; float s = 0.f;
#pragma unroll
        for (int j = 0; j < 4; ++j) { v[j] = xr[64 * j]; s += (v[j].x * v[j].x + v[j].y * v[j].y) + (v[j].z * v[j].z + v[j].w * v[j].w); }
        const float rstd = 1.0f / sqrtf(wave_sum(s) * (1.0f / D) + EPS);
#pragma unroll
        for (int j = 0; j < 4; ++j) { const f32x4 gv = *(const f32x4*)(g + 4 * (64 * j + F.lane)); xr[64 * j] = (f32x4){v[j].x * rstd * gv.x, v[j].y * rstd * gv.y, v[j].z * rstd * gv.z, v[j].w * rstd * gv.w}; }
    }
}

#define XB_TMO      128
#define XB_XCNT(j)  (256  + 64 * (j))
#define XB_XSUB(j)  (1280 + 64 * (j))
#define XB_XGEN(j)  (2304 + 64 * (j))
#define XB_TOP      3328
#define XB_TOPGEN   3392
#define XCD_BAR_WORDS 3456
#define XB_SPIN_CAP (1u << 20)
__device__ __forceinline__ unsigned xb_ld(unsigned* p)              { return __hip_atomic_load(p, __ATOMIC_RELAXED, __HIP_MEMORY_SCOPE_AGENT); }
__device__ __forceinline__ unsigned xb_add(unsigned* p, unsigned v) { return __hip_atomic_fetch_add(p, v, __ATOMIC_RELAXED, __HIP_MEMORY_SCOPE_AGENT); }
__device__ __forceinline__ unsigned xb_xcc_id() { return (unsigned)__builtin_amdgcn_s_getreg((3 << 11) | 20) & 0xFu; }
#define XB_SPIN(cond, bar) do { unsigned _sp = 0; while (cond) { __builtin_amdgcn_s_sleep(1); \
    if ((++_sp & 255u) == 0u) { if (xb_ld(&(bar)[XB_TMO])) break; if (_sp > XB_SPIN_CAP) { atomicAdd(&(bar)[XB_TMO], 1u); break; } } } } while (0)
struct XcdBarrier { unsigned* bar; unsigned x; volatile LAS unsigned* st; };
__device__ __forceinline__ XcdBarrier xcd_barrier_post(unsigned* bar, volatile LAS unsigned* st) {
    XcdBarrier b; b.bar = bar; b.x = xb_xcc_id(); b.st = st;
    if (threadIdx.x == 0) (void)xb_add(&bar[XB_XCNT(b.x)], 1u);
    return b;
}
__device__ __forceinline__ void xcd_barrier_complete(unsigned* bar, unsigned x, unsigned& nloc, unsigned& nx) {
    const unsigned G = gridDim.x * gridDim.y * gridDim.z;
    unsigned sum, cnt, mine, sp = 0u;
    for (;;) {
        sum = 0u; cnt = 0u; mine = 0u;
#pragma unroll
        for (unsigned j = 0; j < 16; ++j) { const unsigned c = xb_ld(&bar[XB_XCNT(j)]); sum += c; cnt += (c > 0u) ? 1u : 0u; mine = (j == x) ? c : mine; }
        if (sum == G) break;
        __builtin_amdgcn_s_sleep(1);
        if ((++sp & 255u) == 0u) { if (xb_ld(&bar[XB_TMO])) break; if (sp > XB_SPIN_CAP) { atomicAdd(&bar[XB_TMO], 1u); break; } }
    }
    nloc = mine > 0u ? mine : 1u; nx = cnt > 0u ? cnt : 1u;
}
__device__ __forceinline__ void xcd_barrier(const XcdBarrier& b) {
    asm volatile("s_waitcnt vmcnt(0)" ::: "memory");
    __syncthreads();
    if (threadIdx.x == 0) {
        unsigned* bar = b.bar;
        __builtin_amdgcn_s_waitcnt(0);
        unsigned nloc = b.st[0], nx = b.st[1];
        if (nloc == 0u) { xcd_barrier_complete(bar, b.x, nloc, nx); b.st[0] = nloc; b.st[1] = nx; }
        const unsigned old = xb_add(&bar[XB_XSUB(b.x)], 1u);
        const unsigned gen = old / nloc;
        if (old + 1u == (gen + 1u) * nloc) {
            __builtin_amdgcn_fence(__ATOMIC_RELEASE, "agent");
            asm volatile("s_waitcnt vmcnt(0)" ::: "memory");
            const unsigned og = xb_add(&bar[XB_TOP], 1u);
            const unsigned tg = og / nx;
            if (og + 1u == (tg + 1u) * nx) xb_add(&bar[XB_TOPGEN], 1u);
            else XB_SPIN(xb_ld(&bar[XB_TOPGEN]) == tg, bar);
            __builtin_amdgcn_fence(__ATOMIC_ACQUIRE, "agent");
            xb_add(&bar[XB_XGEN(b.x)], 1u);
            asm volatile("s_waitcnt vmcnt(0)" ::: "memory");
        } else {
            XB_SPIN(xb_ld(&bar[XB_XGEN(b.x)]) == gen, bar);
            __builtin_amdgcn_fence(__ATOMIC_ACQUIRE, "agent");
            asm volatile("s_waitcnt vmcnt(0)" ::: "memory");
        }
    }
    __syncthreads();
}

constexpr int NPHASES = 16;
#ifndef REF_ATTN
#define REF_ATTN 0
#endif
#ifndef REF_GEMM
#define REF_GEMM 0
#endif
#ifndef PHMASK
#define PHMASK 0xFFFF
#endif
#define PHM(k) ((PHMASK >> (k)) & 1)
template <int l>
__device__ __forceinline__ void layer_phases(const Args& args, Frame& F, const XcdBarrier& bar, const int lo, const int hi) {
    constexpr int pb = 1 + 7 * l;
#define IN(k) (lo <= (k) && (k) < hi)
#define SEAM(k) do { if (N_LAUNCHES == 1 && IN(k) && IN((k) + 1)) xcd_barrier(bar); } while (0)

        if (IN(pb + 0)) { if (PHM(1)) { norm_phase(args, F, l, 0); cache_phase(args, F, l); } }
        SEAM(pb + 0);
        if (IN(pb + 1)) { if (PHM(2)) {
#if REF_GEMM
            RefEpiIn E{&args, l}; ref_gemm<16, RefEpiIn>(F.lds, (const bf16*)(args.ws + WS_H), (const bf16*)(args.ws + WS_WIN) + (size_t)l * NIN * D, M, NIN, D, E);
#else
            pg8::Gemm g{(const bf16*)(args.ws + WS_H), (const bf16*)(args.ws + WS_WIN) + (size_t)l * NIN * D, M, NIN, D}; pg8::StaticOrder S; S.init(M, NIN, (int)gridDim.x, (int)blockIdx.x);
            pg8::EpiIn E{args.ws, args.out, l}; pg8::gemm_phase<pg8::EpiIn, pg8::StaticOrder, true, true>(F.lds, g, S, E);
#endif
        } }
        SEAM(pb + 1);
        if (IN(pb + 2)) { if (PHM(3)) {
#if REF_ATTN
            attn_ref(args, F, l); __syncthreads();
#else
            attn_phase(args, F, l);
#endif
        } if (PHM(9)) pool_phase(args, F, l); if (PHM(10)) sgu_ref(args, F, l); }
        SEAM(pb + 2);
        if (IN(pb + 3)) { if (PHM(4)) {
#if REF_GEMM
            RefEpiRes E{&args, &F, l, 2, l == 0 ? 1 : 0}; ref_gemm<16, RefEpiRes>(F.lds, (const bf16*)(args.ws + WS_MIX), (const bf16*)(args.ws + WS_WOUT) + (size_t)l * D * D, M, D, D, E);
#else
            pg8::Gemm g{(const bf16*)(args.ws + WS_MIX), (const bf16*)(args.ws + WS_WOUT) + (size_t)l * D * D, M, D, D}; pg8::StaticOrder S; S.init(M, D, (int)gridDim.x, (int)blockIdx.x);
            pg8::EpiRes E{inp(F, 0), inp(F, 1), args.out, (const float*)(args.ws + WS_MOD) + (size_t)l * NCOND * NMOD + 2 * D, l == 0 ? 1 : 0};
            pg8::gemm_phase<pg8::EpiRes, pg8::StaticOrder, true, true>(F.lds, g, S, E);
#endif
        } }
        SEAM(pb + 3);
        if (IN(pb + 4)) { if (PHM(5)) norm_phase(args, F, l, 1); }
        SEAM(pb + 4);
        if (IN(pb + 5)) { if (PHM(6)) {
#if REF_GEMM
            RefEpiSwiglu E{&args}; ref_gemm<64, RefEpiSwiglu>(F.lds, (const bf16*)(args.ws + WS_H), (const bf16*)(args.ws + WS_WF1) + (size_t)l * 2 * DFF * D, M, 2 * DFF, D, E);
#else
            pg8::Gemm g{(const bf16*)(args.ws + WS_H), (const bf16*)(args.ws + WS_WF1) + (size_t)l * 2 * DFF * D, M, 2 * DFF, D}; pg8::StaticOrder S; S.init(M, 2 * DFF, (int)gridDim.x, (int)blockIdx.x);
            pg8::EpiSwiglu E{(bf16*)(args.ws + WS_ACT)}; pg8::gemm_phase<pg8::EpiSwiglu, pg8::StaticOrder, true, true>(F.lds, g, S, E);
#endif
        } }
        SEAM(pb + 5);
        if (IN(pb + 6)) { if (PHM(7)) {
#if REF_GEMM
            RefEpiRes E{&args, &F, l, 5, 0}; ref_gemm<16, RefEpiRes>(F.lds, (const bf16*)(args.ws + WS_ACT), (const bf16*)(args.ws + WS_WF2) + (size_t)l * D * DFF, M, D, DFF, E);
#else
            pg8::Gemm g{(const bf16*)(args.ws + WS_ACT), (const bf16*)(args.ws + WS_WF2) + (size_t)l * D * DFF, M, D, DFF}; pg8::StaticOrder S; S.init(M, D, (int)gridDim.x, (int)blockIdx.x);
            pg8::EpiRes E{inp(F, 0), inp(F, 1), args.out, (const float*)(args.ws + WS_MOD) + (size_t)l * NCOND * NMOD + 5 * D, 0};
            pg8::gemm_phase<pg8::EpiRes, pg8::StaticOrder, true, true>(F.lds, g, S, E);
#endif
        } }
        SEAM(pb + 6);

#undef IN
#undef SEAM
}

__global__ void __launch_bounds__(NTHREADS, 2) mk_fwd(Args args) {
    extern __shared__ __attribute__((aligned(16))) unsigned char lds_raw[];
    Frame F;
    F.lds = (LAS unsigned char*)lds_raw;
    F.tid = threadIdx.x; F.lane = F.tid & 63; F.wave = __builtin_amdgcn_readfirstlane(F.tid >> 6);
    const int lo = args.ph_lo, hi = args.ph_hi;
    for (int u = F.tid; u < 256; u += NTHREADS) ((LAS unsigned*)(F.lds + LDSCTL_OFF))[u] = 0u;
    __syncthreads();
    if (F.tid < 25) ((LAS unsigned long long*)(F.lds + LDSCTL_OFF + 64))[F.tid] = (unsigned long long)args.in[F.tid];
    __syncthreads();
    XcdBarrier bar; bar.bar = (unsigned*)(args.ws + WS_CTL) + CW_BAR; bar.x = 0; bar.st = (volatile LAS unsigned*)(F.lds + LDSCTL_OFF) + 8;
    if (N_LAUNCHES == 1) bar = xcd_barrier_post((unsigned*)(args.ws + WS_CTL) + CW_BAR, (volatile LAS unsigned*)(F.lds + LDSCTL_OFF) + 8);
#define IN(k) (lo <= (k) && (k) < hi)
#define SEAM(k) do { if (N_LAUNCHES == 1 && IN(k) && IN((k) + 1)) xcd_barrier(bar); } while (0)
    if (IN(0)) { if (PHM(0)) { p0_ada(args, F); p0_weights(args, F); p0_misc(args, F); } }
    SEAM(0);
    layer_phases<0>(args, F, bar, lo, hi);
    layer_phases<1>(args, F, bar, lo, hi);
    if (IN(15)) { if (PHM(8)) final_phase(args, F); }
#undef IN
#undef SEAM
}

extern "C" void kernel_launch(void* const* d_in, const int* in_sizes, int n_in, void* d_out, int out_size, void* d_ws, size_t ws_size, hipStream_t stream) {
    static int grid = 0;
    if (grid == 0) {
        if (n_in != 25 || ws_size < WS_END) { fprintf(stderr, "kernel_launch: expected 25 inputs and >= %zu bytes of workspace; got %d, %zu\n", (size_t)WS_END, n_in, ws_size); grid = -1; return; }
        int dev = 0, cus = 0;
        if (hipGetDevice(&dev) != hipSuccess || hipDeviceGetAttribute(&cus, hipDeviceAttributeMultiprocessorCount, dev) != hipSuccess) { grid = -1; return; }
        if (hipFuncSetAttribute((const void*)mk_fwd, hipFuncAttributeMaxDynamicSharedMemorySize, LDS_BYTES) != hipSuccess) { fprintf(stderr, "kernel_launch: hipFuncSetAttribute failed\n"); grid = -1; return; }
        grid = cus;
    }
    if (grid < 0) return;
    Args a{};
    for (int i = 0; i < 25; ++i) a.in[i] = (const float*)d_in[i];
    a.out = (float*)d_out; a.ws = (unsigned char*)d_ws;
    if (hipMemsetAsync((char*)d_ws + WS_CTL, 0, CTL_ZERO_BYTES, stream) != hipSuccess) { fprintf(stderr, "kernel_launch: hipMemsetAsync failed\n"); return; }
    if (N_LAUNCHES == 1) {
        a.ph_lo = 0; a.ph_hi = NPHASES;
        hipLaunchKernelGGL(mk_fwd, dim3(grid), dim3(NTHREADS), LDS_BYTES, stream, a);
    } else {
        for (int ph = 0; ph < NPHASES; ++ph) {
            a.ph_lo = ph; a.ph_hi = ph + 1;
            hipLaunchKernelGGL(mk_fwd, dim3(grid), dim3(NTHREADS), LDS_BYTES, stream, a);
        }
    }
}
```

```cpp
#include <hip/hip_runtime.h>
#include <cstdio>
#include <cstdint>

#define LAS __attribute__((address_space(3)))
typedef unsigned short bf16;
typedef float f32x4 __attribute__((ext_vector_type(4)));
typedef unsigned u32x4 __attribute__((ext_vector_type(4)));
typedef unsigned u32x2 __attribute__((ext_vector_type(2)));

constexpr int D = 1024, MP = 4096, MS = 8192, M = MP + MS;
constexpr int LP = 256, LS = 1024, PAST = 256, LKS = PAST + LS;
constexpr int NIN = 2304, DFF = 2816, NMOD = 6 * D, NCOND = 9;
constexpr int NTHREADS = 512, NWAVES = 8;
constexpr float EPS = 1e-6f;
constexpr float QSCALE = 0.125f * 1.4426950408889634f;
constexpr int C_POOL = 0, C_Q = 256, C_K = 768, C_V = 1280, C_U = 1792, C_VG = 2048;
constexpr size_t OUT_YP = 0, OUT_YS = (size_t)MP * D, OUT_K = (size_t)M * D, OUT_V = OUT_K + (size_t)16 * 2 * 256 * 512;

constexpr size_t MiB = 1u << 20;
constexpr size_t WS_CTL = 0;
constexpr size_t WS_MOD = 1 * MiB;
constexpr size_t WS_ROPE = WS_MOD + 512 * 1024;
constexpr size_t WS_LAM = WS_ROPE + 16 * 1024;
constexpr size_t WS_WIN = 2 * MiB;
constexpr size_t WS_WOUT = WS_WIN + (size_t)2 * NIN * D * 2;
constexpr size_t WS_WF1 = WS_WOUT + (size_t)2 * D * D * 2;
constexpr size_t WS_WF2 = WS_WF1 + (size_t)2 * 2 * DFF * D * 2;
constexpr size_t WS_H = WS_WF2 + (size_t)2 * D * DFF * 2;
constexpr size_t WS_Q = WS_H + (size_t)M * D * 2;
constexpr size_t WS_KP = WS_Q + (size_t)M * 512 * 2;
constexpr size_t WS_KS = WS_KP + (size_t)16 * 256 * 512 * 2;
constexpr size_t WS_VTP = WS_KS + (size_t)8 * LKS * 512 * 2;
constexpr size_t WS_VTS = WS_VTP + (size_t)16 * 4 * 128 * 256 * 2;
constexpr size_t WS_PP = WS_VTS + (size_t)8 * 4 * 128 * LKS * 2;
constexpr size_t WS_U = WS_PP + (size_t)M * 256 * 2;
constexpr size_t WS_VG = WS_U + (size_t)M * 256 * 2;
constexpr size_t WS_MIX = WS_VG + (size_t)M * 256 * 2;
constexpr size_t WS_ACT = WS_MIX + (size_t)M * D * 2;
constexpr size_t WS_END = WS_ACT + (size_t)M * DFF * 2;
static_assert(WS_END <= 256 * MiB, "d_ws map exceeds 256 MiB");

constexpr int PHASE_LDS = 147456;
constexpr int LDSCTL_OFF = PHASE_LDS;
constexpr int LDS_BYTES = PHASE_LDS + 1024;
constexpr int CW_BAR = 4096;
constexpr size_t CTL_ZERO_BYTES = 65536;
#ifndef N_LAUNCHES
#define N_LAUNCHES 1
#endif

__device__ __forceinline__ unsigned f2bf(float f) { unsigned u = __builtin_bit_cast(unsigned, f); return (u + 0x7fffu + ((u >> 16) & 1u)) >> 16; }
__device__ __forceinline__ unsigned pk2(float lo, float hi) { return f2bf(lo) | (f2bf(hi) << 16); }
__device__ __forceinline__ float bf2f(unsigned b) { return __builtin_bit_cast(float, b << 16); }
__device__ __forceinline__ float bflo(unsigned w) { return __builtin_bit_cast(float, w << 16); }
__device__ __forceinline__ float bfhi(unsigned w) { return __builtin_bit_cast(float, w & 0xffff0000u); }
__device__ __forceinline__ float wave_sum(float v) {
#pragma unroll
    for (int o = 1; o < 64; o <<= 1) v += __shfl_xor(v, o);
    return v;
}
__device__ __forceinline__ float wave_max(float v) {
#pragma unroll
    for (int o = 1; o < 64; o <<= 1) v = fmaxf(v, __shfl_xor(v, o));
    return v;
}
__device__ __forceinline__ int perm16(int t) { return (t & ~12) | ((t & 4) << 1) | ((t & 8) >> 1); }
__device__ __forceinline__ float gelu_tanh(float x) {
    const float u = 0.7978845608028654f * (x + 0.044715f * x * x * x);
    const float e = __expf(2.0f * u);
    const float t = 1.0f - 2.0f / (e + 1.0f);
    return 0.5f * x * (1.0f + t);
}
__device__ __forceinline__ float silu_f(float x) { return x / (1.0f + __expf(-x)); }
__device__ __forceinline__ int cond_of_row(int m) { return m < MP ? 8 : ((m - MP) >> 10); }

struct Args {
    const float* in[25];
    float* out;
    unsigned char* ws;
    int ph_lo, ph_hi;
};

struct Frame {
    LAS unsigned char* lds;
    int tid, lane, wave;
};
__device__ __forceinline__ const float* inp(const Frame& F, int i) {
    const LAS unsigned* t = (const LAS unsigned*)(F.lds + PHASE_LDS + 64) + 2 * i;
    const unsigned lo = __builtin_amdgcn_readfirstlane(t[0]), hi = __builtin_amdgcn_readfirstlane(t[1]);
    typedef __attribute__((address_space(1))) const float gcf;
    return (const float*)(gcf*)(((unsigned long long)hi << 32) | (unsigned long long)lo);
}

__device__ __forceinline__ void p0_ada(const Args& a, Frame& F) {
    LAS float* sc = (LAS float*)F.lds;
    LAS float* red = sc + NCOND * D;
    const float* c = inp(F, 4); const float* cctx = inp(F, 5);
    const float* w_ada = inp(F, 7); const float* b_ada = inp(F, 8);
    float* mod = (float*)(a.ws + WS_MOD);
    bool have = false;
    for (int item = blockIdx.x; item < 2 * 96; item += gridDim.x) {
        if (!have) {
            for (int i = F.tid; i < NCOND * D; i += NTHREADS) { const int b = i >> 10, k = i & 1023; const float v = (b < 8) ? c[b * D + k] : cctx[k]; sc[i] = silu_f(v); }
            have = true;
        }
        __syncthreads();
        const int l = item / 96, n = (item % 96) * 64 + F.lane;
        const float* wp = w_ada + (size_t)l * D * NMOD + n;
        float acc[NCOND];
#pragma unroll
        for (int b = 0; b < NCOND; ++b) acc[b] = 0.f;
        const int k0 = F.wave * 128;
#pragma unroll 4
        for (int kk = 0; kk < 128; kk += 4) {
            const int k = k0 + kk;
            const float w0 = wp[(size_t)(k + 0) * NMOD], w1 = wp[(size_t)(k + 1) * NMOD], w2 = wp[(size_t)(k + 2) * NMOD], w3 = wp[(size_t)(k + 3) * NMOD];
#pragma unroll
            for (int b = 0; b < NCOND; ++b) { const f32x4 s = *(const LAS f32x4*)(sc + b * D + k); acc[b] += s.x * w0 + s.y * w1 + s.z * w2 + s.w * w3; }
        }
#pragma unroll
        for (int b = 0; b < NCOND; ++b) red[(F.wave * NCOND + b) * 64 + F.lane] = acc[b];
        __syncthreads();
        for (int i = F.tid; i < NCOND * 64; i += NTHREADS) {
            const int b = i >> 6, ln = i & 63; float s = 0.f;
#pragma unroll
            for (int w = 0; w < 8; ++w) s += red[(w * NCOND + b) * 64 + ln];
            const int nn = (item % 96) * 64 + ln;
            mod[((size_t)l * NCOND + b) * NMOD + nn] = s + b_ada[(size_t)l * NMOD + nn];
        }
        __syncthreads();
    }
    __syncthreads();
}
__device__ __forceinline__ void p0_transpose_item(const float* W, int K, int N, bf16* WT, int swz_ffn, LAS float* scr, int item, int lane) {
    const int nblk = N / 32, kb = item / nblk, nb = item % nblk, k0 = 64 * kb, n0 = 32 * nb;
#pragma unroll 8
    for (int i = 0; i < 32; ++i) { const int kk = 2 * i + (lane >> 5); scr[kk * 33 + (lane & 31)] = W[(size_t)(k0 + kk) * N + n0 + (lane & 31)]; }
    asm volatile("s_waitcnt lgkmcnt(0)" ::: "memory");
    int r0 = n0;
    if (swz_ffn) { r0 = (n0 < DFF) ? ((n0 >> 7) * 256 + (n0 & 127)) : (((n0 - DFF) >> 7) * 256 + 128 + ((n0 - DFF) & 127)); }
    const int c = lane & 7;
#pragma unroll
    for (int j = 0; j < 4; ++j) { const int n = (lane >> 3) + 8 * j; const LAS float* s = scr + (8 * c) * 33 + n;
        u32x4 o; o.x = pk2(s[0 * 33], s[1 * 33]); o.y = pk2(s[2 * 33], s[3 * 33]); o.z = pk2(s[4 * 33], s[5 * 33]); o.w = pk2(s[6 * 33], s[7 * 33]);
        *(u32x4*)(WT + (size_t)(r0 + n) * K + k0 + 8 * c) = o; }
    asm volatile("s_waitcnt lgkmcnt(0)" ::: "memory");
}
__device__ __forceinline__ void p0_weights(const Args& a, Frame& F) {
    LAS float* scr = (LAS float*)(F.lds) + F.wave * (64 * 33);
    const int gw = blockIdx.x * NWAVES + F.wave, NGW = gridDim.x * NWAVES;
    constexpr int I_IN = (D / 64) * (NIN / 32), I_OUT = (D / 64) * (D / 32), I_F1 = (D / 64) * (2 * DFF / 32), I_F2 = (DFF / 64) * (D / 32);
    constexpr int PER_L = I_IN + I_OUT + I_F1 + I_F2;
    for (int it = gw; it < 2 * PER_L; it += NGW) {
        const int l = it / PER_L; int r = it % PER_L;
        if (r < I_IN) { p0_transpose_item(inp(F, 9) + (size_t)l * D * NIN, D, NIN, (bf16*)(a.ws + WS_WIN) + (size_t)l * NIN * D, 0, scr, r, F.lane); continue; } r -= I_IN;
        if (r < I_OUT) { p0_transpose_item(inp(F, 20) + (size_t)l * D * D, D, D, (bf16*)(a.ws + WS_WOUT) + (size_t)l * D * D, 0, scr, r, F.lane); continue; } r -= I_OUT;
        if (r < I_F1) { p0_transpose_item(inp(F, 22) + (size_t)l * D * 2 * DFF, D, 2 * DFF, (bf16*)(a.ws + WS_WF1) + (size_t)l * 2 * DFF * D, 1, scr, r, F.lane); continue; } r -= I_F1;
        p0_transpose_item(inp(F, 23) + (size_t)l * DFF * D, DFF, D, (bf16*)(a.ws + WS_WF2) + (size_t)l * D * DFF, 0, scr, r, F.lane);
    }
}
__device__ __forceinline__ void p0_misc(const Args& a, Frame& F) {
    if (blockIdx.x == gridDim.x - 1) {
        float* rope = (float*)(a.ws + WS_ROPE);
        for (int i = F.tid; i < 64 * 16; i += NTHREADS) {
            const int pos = i >> 4, fi = i & 15;
            const float inv = (float)(1.0 / pow(10000.0, (double)fi / 16.0));
            const float ang = (float)pos * inv;
            rope[i] = (float)cos((double)ang); rope[1024 + i] = (float)sin((double)ang);
        }
        if (F.wave == 0) {
            float* lam = (float*)(a.ws + WS_LAM);
#pragma unroll
            for (int l = 0; l < 2; ++l) {
                const float d1 = wave_sum(inp(F, 12)[l * 64 + F.lane] * inp(F, 13)[l * 64 + F.lane]);
                const float d2 = wave_sum(inp(F, 14)[l * 64 + F.lane] * inp(F, 15)[l * 64 + F.lane]);
                const float lam_init = (l == 0) ? 0.2f : (float)(0.8 - 0.6 * 0.7408182206817179);
                if (F.lane == 0) lam[l] = expf(d1) - expf(d2) + lam_init;
            }
        }
    }
}

__device__ __forceinline__ const float* xrow_ptr(const Args& a, const Frame& F, int l_first, int m) {
    if (l_first) return (m < MP) ? inp(F, 0) + (size_t)m * D : inp(F, 1) + (size_t)(m - MP) * D;
    return a.out + (size_t)m * D;
}
__device__ __forceinline__ void norm_phase(const Args& a, Frame& F, int l, int which  ) {
    const float* g = (which == 0 ? inp(F, 6) : inp(F, 21)) + (size_t)l * D;
    const float* mod = (const float*)(a.ws + WS_MOD) + (size_t)l * NCOND * NMOD;
    const int sh_off = which == 0 ? 0 : 3 * D, sc_off = which == 0 ? D : 4 * D;
    bf16* H = (bf16*)(a.ws + WS_H);
    const int gw = blockIdx.x * NWAVES + F.wave, NGW = gridDim.x * NWAVES;
    for (int m = gw; m < M; m += NGW) {
        const f32x4* xr = (const f32x4*)xrow_ptr(a, F, (l == 0 && which == 0), m) + F.lane;
        f32x4 v[4]; float s = 0.f;
#pragma unroll
        for (int j = 0; j < 4; ++j) { v[j] = xr[64 * j]; s += (v[j].x * v[j].x + v[j].y * v[j].y) + (v[j].z * v[j].z + v[j].w * v[j].w); }
        const float rstd = 1.0f / sqrtf(wave_sum(s) * (1.0f / D) + EPS);
        const float* mb = mod + (size_t)cond_of_row(m) * NMOD;
        unsigned long long* o8 = (unsigned long long*)(H + (size_t)m * D) + F.lane;
#pragma unroll
        for (int j = 0; j < 4; ++j) {
            const int col = 4 * (64 * j + F.lane);
            const f32x4 gv = *(const f32x4*)(g + col), scv = *(const f32x4*)(mb + sc_off + col), shv = *(const f32x4*)(mb + sh_off + col);
            const float y0 = v[j].x * rstd * gv.x * (1.0f + scv.x) + shv.x, y1 = v[j].y * rstd * gv.y * (1.0f + scv.y) + shv.y;
            const float y2 = v[j].z * rstd * gv.z * (1.0f + scv.z) + shv.z, y3 = v[j].w * rstd * gv.w * (1.0f + scv.w) + shv.w;
            o8[64 * j] = (unsigned long long)pk2(y0, y1) | ((unsigned long long)pk2(y2, y3) << 32);
        }
    }
}
__device__ __forceinline__ void cache_phase(const Args& a, Frame& F, int l) {
    const float* ck = inp(F, 2); const float* cv = inp(F, 3);
    bf16* KS = (bf16*)(a.ws + WS_KS); bf16* VTS = (bf16*)(a.ws + WS_VTS);
    const int gt = blockIdx.x * NTHREADS + F.tid, NT = gridDim.x * NTHREADS;
    for (int i = gt; i < 8 * 256 * 128; i += NT) {
        const int b = i / (256 * 128), r = i % (256 * 128), pos = r / 128, c4 = (r % 128) * 4;
        const f32x4 v = *(const f32x4*)(ck + (((size_t)(b * 2 + l) * 256 + pos) * 512 + c4));
        *(u32x2*)(KS + ((size_t)(b * LKS + pos) * 512 + c4)) = (u32x2){pk2(v.x, v.y), pk2(v.z, v.w)};
    }
    LAS float* T = (LAS float*)F.lds;
    for (int item = blockIdx.x; item < 8 * 4 * 4; item += gridDim.x) {
        const int b = item >> 4, h = (item >> 2) & 3, pblk = item & 3;
        __syncthreads();
        { const int pos = F.tid >> 3, c16 = (F.tid & 7) * 16;
          const float* src = cv + (((size_t)(b * 2 + l) * 256 + pblk * 64 + pos) * 512 + h * 128 + c16);
#pragma unroll
          for (int k = 0; k < 4; ++k) { const f32x4 v = *(const f32x4*)(src + 4 * k); LAS float* d = T + pos * 129 + c16 + 4 * k; d[0] = v.x; d[1] = v.y; d[2] = v.z; d[3] = v.w; } }
        __syncthreads();
        { const int d = F.tid >> 2, ch = F.tid & 3;
          unsigned w[8];
#pragma unroll
          for (int k = 0; k < 8; ++k) { const int p0 = 16 * ch + perm16(2 * k), p1 = 16 * ch + perm16(2 * k + 1); w[k] = pk2(T[p0 * 129 + d], T[p1 * 129 + d]); }
          bf16* dst = VTS + ((size_t)(b * 4 + h) * 128 + d) * LKS + pblk * 64 + 16 * ch;
          *(u32x4*)dst = (u32x4){w[0], w[1], w[2], w[3]}; *(u32x4*)(dst + 8) = (u32x4){w[4], w[5], w[6], w[7]}; }
    }
    __syncthreads();
}

template <int TX, class Epi>
__device__ __forceinline__ void ref_gemm(LAS unsigned char* lds, const bf16* A, const bf16* Bt, int Mr, int N, int K, const Epi& epi) {
    constexpr int TY = NTHREADS / TX, BMn = 4 * TY, BNn = 4 * TX;
    LAS float* As = (LAS float*)lds;
    LAS float* Bs = As + BMn * 33;
    const int tid = threadIdx.x, tx = tid % TX, ty = tid / TX;
    const int ntn = N / BNn, ntm = Mr / BMn;
    for (int tile = blockIdx.x; tile < ntm * ntn; tile += gridDim.x) {
        const int tm = tile / ntn, tn = tile % ntn;
        float acc[4][4];
#pragma unroll
        for (int i = 0; i < 4; ++i)
#pragma unroll
            for (int j = 0; j < 4; ++j) acc[i][j] = 0.f;
        for (int k0 = 0; k0 < K; k0 += 32) {
            __syncthreads();
            for (int ch = tid; ch < BMn * 4; ch += NTHREADS) { const int r = ch >> 2, c8 = (ch & 3) * 8;
                const u32x4 v = *(const u32x4*)(A + (size_t)(tm * BMn + r) * K + k0 + c8); LAS float* d = As + r * 33 + c8;
                d[0] = bflo(v.x); d[1] = bfhi(v.x); d[2] = bflo(v.y); d[3] = bfhi(v.y); d[4] = bflo(v.z); d[5] = bfhi(v.z); d[6] = bflo(v.w); d[7] = bfhi(v.w); }
            for (int ch = tid; ch < BNn * 4; ch += NTHREADS) { const int r = ch >> 2, c8 = (ch & 3) * 8;
                const u32x4 v = *(const u32x4*)(Bt + (size_t)(tn * BNn + r) * K + k0 + c8); LAS float* d = Bs + r * 33 + c8;
                d[0] = bflo(v.x); d[1] = bfhi(v.x); d[2] = bflo(v.y); d[3] = bfhi(v.y); d[4] = bflo(v.z); d[5] = bfhi(v.z); d[6] = bflo(v.w); d[7] = bfhi(v.w); }
            __syncthreads();
#pragma unroll 8
            for (int kk = 0; kk < 32; ++kk) {
                float av[4], bv[4];
#pragma unroll
                for (int i = 0; i < 4; ++i) av[i] = As[(ty + TY * i) * 33 + kk];
#pragma unroll
                for (int j = 0; j < 4; ++j) bv[j] = Bs[(tx + TX * j) * 33 + kk];
#pragma unroll
                for (int i = 0; i < 4; ++i)
#pragma unroll
                    for (int j = 0; j < 4; ++j) acc[i][j] += av[i] * bv[j];
            }
        }
#pragma unroll
        for (int i = 0; i < 4; ++i) epi(tm * BMn + ty + TY * i, tn * BNn, tx, acc[i]);
    }
    __syncthreads();
}

struct RefEpiIn {
    const Args* a; int l;
    __device__ __forceinline__ void operator()(int m, int cb, int tx, const float (&v)[4]) const {
        unsigned char* ws = a->ws;
        const bool smp = m >= MP;
        const int b = smp ? ((m - MP) >> 10) : (m >> 8), t = smp ? ((m - MP) & 1023) : (m & 255);
        if (cb < C_Q) {
            bf16* P = (bf16*)(ws + WS_PP) + (size_t)m * 256 + cb + tx;
#pragma unroll
            for (int j = 0; j < 4; ++j) P[16 * j] = (bf16)f2bf(v[j]);
        } else if (cb < C_V) {
            float o[4] = {v[0], v[1], v[2], v[3]};
            if (smp) {
                const float* rope = (const float*)(ws + WS_ROPE);
                const int pr = t >> 6, pc = t & 63;
                const float cr = rope[pr * 16 + tx], sr = rope[1024 + pr * 16 + tx], cc = rope[pc * 16 + tx], sn = rope[1024 + pc * 16 + tx];
                o[0] = v[0] * cr - v[1] * sr; o[1] = v[1] * cr + v[0] * sr;
                o[2] = v[2] * cc - v[3] * sn; o[3] = v[3] * cc + v[2] * sn;
            }
            if (cb < C_K) {
                bf16* Q = (bf16*)(ws + WS_Q) + (size_t)m * 512 + (cb - C_Q) + tx;
#pragma unroll
                for (int j = 0; j < 4; ++j) Q[16 * j] = (bf16)f2bf(o[j] * QSCALE);
            } else {
                const int col = (cb - C_K) + tx;
                bf16* Kd = smp ? (bf16*)(ws + WS_KS) + ((size_t)(b * LKS + PAST + t) * 512 + col) : (bf16*)(ws + WS_KP) + ((size_t)(b * LP + t) * 512 + col);
#pragma unroll
                for (int j = 0; j < 4; ++j) Kd[16 * j] = (bf16)f2bf(o[j]);
                if (!smp) { float* ok = a->out + OUT_K + ((size_t)(b * 2 + l) * 256 + t) * 512 + col;
#pragma unroll
                    for (int j = 0; j < 4; ++j) ok[16 * j] = o[j]; }
            }
        } else if (cb < C_U) {
#pragma unroll
            for (int j = 0; j < 4; ++j) {
                const int col = (cb - C_V) + tx + 16 * j, h = col >> 7, d = col & 127;
                if (smp) ((bf16*)(ws + WS_VTS))[((size_t)(b * 4 + h) * 128 + d) * LKS + PAST + perm16(t)] = (bf16)f2bf(v[j]);
                else { ((bf16*)(ws + WS_VTP))[((size_t)(b * 4 + h) * 128 + d) * LP + perm16(t)] = (bf16)f2bf(v[j]);
                       a->out[OUT_V + ((size_t)(b * 2 + l) * 256 + t) * 512 + col] = v[j]; }
            }
        } else {
            bf16* U = (cb < C_VG) ? (bf16*)(ws + WS_U) + (size_t)m * 256 + (cb - C_U) + tx : (bf16*)(ws + WS_VG) + (size_t)m * 256 + (cb - C_VG) + tx;
#pragma unroll
            for (int j = 0; j < 4; ++j) U[16 * j] = (bf16)f2bf(gelu_tanh(v[j]));
        }
    }
};
struct RefEpiRes {
    const Args* a; const Frame* Fp; int l; int gi; int first;
    __device__ __forceinline__ void operator()(int m, int cb, int tx, const float (&v)[4]) const {
        const float* src = xrow_ptr(*a, *Fp, first, m);
        const float* gate = (const float*)(a->ws + WS_MOD) + ((size_t)l * NCOND + cond_of_row(m)) * NMOD + gi * D;
        float* X = a->out + (size_t)m * D;
#pragma unroll
        for (int j = 0; j < 4; ++j) { const int n = cb + tx + 16 * j; X[n] = src[n] + gate[n] * v[j]; }
    }
};
struct RefEpiSwiglu {
    const Args* a;
    __device__ __forceinline__ void operator()(int m, int cb, int tx, const float (&v)[4]) const {
        bf16* ACT = (bf16*)(a->ws + WS_ACT) + (size_t)m * DFF + (cb >> 1) + tx;
        ACT[0] = (bf16)f2bf(silu_f(v[0]) * v[2]);
        ACT[64] = (bf16)f2bf(silu_f(v[1]) * v[3]);
    }
};

namespace pg8 {
#define PG8_LAS __attribute__((address_space(3)))
typedef unsigned short bf16_t;
typedef short bf16x8 __attribute__((ext_vector_type(8)));
typedef float f32x4 __attribute__((ext_vector_type(4)));
typedef unsigned u32x4 __attribute__((ext_vector_type(4)));
constexpr int BM = 256, BK = 64, HALF = 128, HTB = HALF * BK * 2  , STAGE_BYTES = 8 * HTB, NXCD = 8, WGM = 8;

__host__ __device__ __forceinline__ int lds_byte(int r, int c) { const int st = (r >> 4) * 2 + (c >> 5), rr = r & 15, cc = c & 31, ob = rr * 64 + cc * 2; return st * 1024 + (ob ^ (((ob >> 9) & 1) << 5)); }
__host__ __device__ __forceinline__ void stage_rc(int b, int& R, int& C) { const int st = b / 1024, sb = b % 1024, swz = sb ^ (((sb >> 9) & 1) << 5); R = (st >> 1) * 16 + swz / 64; C = (st & 1) * 32 + (swz % 64) / 2; }
__host__ __device__ __forceinline__ int perm32(int rho) { const int n = rho >> 4, i = rho & 15; return 8 * (i >> 2) + 4 * n + (i & 3); }

struct Unit { int pm, pn; };
struct Gemm { const bf16_t* A; const bf16_t* Bt; int M, N, K; };

struct StaticOrder {
    int nM, nN, nwg, G, c;
    __host__ __device__ void init(int M, int N, int G_, int c_) { nM = M / BM; nN = N / BM; nwg = nM * nN; G = G_; c = c_; }
    __host__ __device__ bool next(int i, Unit& u) const {
        const long L = (long)i * G + c; if (L >= nwg) return false;
        int wgid = (int)L; { const int q = nwg / NXCD, r = nwg % NXCD, xcd = wgid % NXCD, off = wgid / NXCD; wgid = (xcd < r ? xcd * (q + 1) : r * (q + 1) + (xcd - r) * q) + off; }
        const int nig = WGM * nN, gid = wgid / nig, fm = gid * WGM, gsz = (nM - fm) < WGM ? (nM - fm) : WGM;
        u.pm = fm + ((wgid % nig) % gsz); u.pn = (wgid % nig) / gsz; return true;
    }
    __device__ __forceinline__ void a_ready(const Unit&) const {}
    __device__ __forceinline__ void done(const Unit&) const {}
};
__device__ __forceinline__ unsigned cvt_pk_bf16(float lo, float hi) { unsigned r; asm volatile("v_cvt_pk_bf16_f32 %0, %1, %2" : "=v"(r) : "v"(lo), "v"(hi)); return r; }

__device__ __forceinline__ float fast_silu(float x) { return x * __builtin_amdgcn_rcpf(1.0f + __expf(-x)); }
__device__ __forceinline__ float fast_gelu_tanh(float x) {
    const float u = 0.7978845608028654f * (x + 0.044715f * x * x * x);
    const float t = 1.0f - 2.0f * __builtin_amdgcn_rcpf(__expf(2.0f * u) + 1.0f);
    return 0.5f * x * (1.0f + t);
}
typedef unsigned u32x2v __attribute__((ext_vector_type(2)));
struct EpiIn {
    static constexpr bool PERM = false, AFTER_DRAIN = false;
    unsigned char* ws; float* out; int l;
    __device__ __forceinline__ void operator()(const f32x4 (&acc)[2][2][4][2], const Unit& u, int wr, int wc, int fr, int fq) const {
        const bool smp = u.pm >= 16;
        const int b = smp ? ((u.pm - 16) >> 2) : u.pm;
        const int tb = (smp ? ((u.pm - 16) & 3) * 256 : 0) + wr * 64 + fr;
        const int rowb = u.pm * BM + wr * 64 + fr;
        const int pn = u.pn;
        if (pn == 0) {
            bf16_t* P = (bf16_t*)(ws + WS_PP) + (size_t)rowb * 256 + wc * 32 + 4 * fq;
#pragma unroll
            for (int ai = 0; ai < 2; ++ai)
#pragma unroll
                for (int m = 0; m < 4; ++m)
#pragma unroll
                    for (int bj = 0; bj < 2; ++bj)
#pragma unroll
                        for (int n = 0; n < 2; ++n) { const f32x4 v = acc[ai][bj][m][n];
                            *(u32x2v*)(P + (size_t)(ai * HALF + m * 16) * 256 + bj * HALF + n * 16) = (u32x2v){cvt_pk_bf16(v[0], v[1]), cvt_pk_bf16(v[2], v[3])}; }
        } else if (pn <= 4) {
            const bool isq = pn <= 2;
            const int colt = (isq ? (pn - 1) : (pn - 3)) * 256 + wc * 32 + 4 * fq;
            const float* rope = (const float*)(ws + WS_ROPE);
#pragma unroll
            for (int ai = 0; ai < 2; ++ai)
#pragma unroll
                for (int m = 0; m < 4; ++m) {
                    const int t = tb + ai * HALF + m * 16, row = rowb + ai * HALF + m * 16;
                    f32x4 cs = {1.f, 1.f, 1.f, 1.f}, sn = {0.f, 0.f, 0.f, 0.f};
                    if (smp) { const int pos = (wc & 1) ? (t & 63) : (t >> 6); cs = *(const f32x4*)(rope + pos * 16 + 4 * fq); sn = *(const f32x4*)(rope + 1024 + pos * 16 + 4 * fq); }
#pragma unroll
                    for (int bj = 0; bj < 2; ++bj) {
                        const f32x4 x1 = acc[ai][bj][m][0], x2 = acc[ai][bj][m][1];
                        f32x4 o1 = x1 * cs - x2 * sn, o2 = x2 * cs + x1 * sn;
                        const int col = colt + bj * HALF;
                        if (isq) {
                            o1 = o1 * QSCALE; o2 = o2 * QSCALE;
                            bf16_t* q = (bf16_t*)(ws + WS_Q) + (size_t)row * 512 + col;
                            *(u32x2v*)(q) = (u32x2v){cvt_pk_bf16(o1[0], o1[1]), cvt_pk_bf16(o1[2], o1[3])};
                            *(u32x2v*)(q + 16) = (u32x2v){cvt_pk_bf16(o2[0], o2[1]), cvt_pk_bf16(o2[2], o2[3])};
                        } else {
                            bf16_t* k = smp ? (bf16_t*)(ws + WS_KS) + ((size_t)(b * LKS + PAST + t) * 512 + col) : (bf16_t*)(ws + WS_KP) + ((size_t)(b * LP + t) * 512 + col);
                            *(u32x2v*)(k) = (u32x2v){cvt_pk_bf16(o1[0], o1[1]), cvt_pk_bf16(o1[2], o1[3])};
                            *(u32x2v*)(k + 16) = (u32x2v){cvt_pk_bf16(o2[0], o2[1]), cvt_pk_bf16(o2[2], o2[3])};
                            if (!smp) { float* ok = out + OUT_K + ((size_t)(b * 2 + l) * 256 + t) * 512 + col; *(f32x4*)ok = o1; *(f32x4*)(ok + 16) = o2; }
                        }
                    }
                }
        } else if (pn <= 6) {
            const int Lk = smp ? LKS : LP, koff = smp ? PAST : 0;
            bf16_t* vt = smp ? (bf16_t*)(ws + WS_VTS) : (bf16_t*)(ws + WS_VTP);
#pragma unroll
            for (int ai = 0; ai < 2; ++ai)
#pragma unroll
                for (int m = 0; m < 4; ++m) {
                    const int t = tb + ai * HALF + m * 16;
                    const int pt = koff + ((t & ~12) | ((t & 4) << 1) | ((t & 8) >> 1));
#pragma unroll
                    for (int bj = 0; bj < 2; ++bj) {
                        const int h = 2 * (pn - 5) + bj;
#pragma unroll
                        for (int n = 0; n < 2; ++n) {
                            const f32x4 v = acc[ai][bj][m][n];
                            const int d0 = wc * 32 + n * 16 + 4 * fq;
                            bf16_t* dst = vt + ((size_t)(b * 4 + h) * 128 + d0) * Lk + pt;
                            const unsigned w01 = cvt_pk_bf16(v[0], v[1]), w23 = cvt_pk_bf16(v[2], v[3]);
                            dst[0] = (bf16_t)(w01 & 0xffffu); dst[(size_t)Lk] = (bf16_t)(w01 >> 16); dst[(size_t)2 * Lk] = (bf16_t)(w23 & 0xffffu); dst[(size_t)3 * Lk] = (bf16_t)(w23 >> 16);
                            if (!smp) *(f32x4*)(out + OUT_V + ((size_t)(b * 2 + l) * 256 + t) * 512 + (pn - 5) * 256 + bj * HALF + d0) = v;
                        }
                    }
                }
        } else {
            bf16_t* U = (bf16_t*)(ws + (pn == 7 ? WS_U : WS_VG)) + (size_t)rowb * 256 + wc * 32 + 4 * fq;
#pragma unroll
            for (int ai = 0; ai < 2; ++ai)
#pragma unroll
                for (int m = 0; m < 4; ++m)
#pragma unroll
                    for (int bj = 0; bj < 2; ++bj)
#pragma unroll
                        for (int n = 0; n < 2; ++n) { const f32x4 v = acc[ai][bj][m][n];
                            *(u32x2v*)(U + (size_t)(ai * HALF + m * 16) * 256 + bj * HALF + n * 16) =
                                (u32x2v){cvt_pk_bf16(fast_gelu_tanh(v[0]), fast_gelu_tanh(v[1])), cvt_pk_bf16(fast_gelu_tanh(v[2]), fast_gelu_tanh(v[3]))}; }
        }
    }
};
struct EpiRes {
    static constexpr bool PERM = false, AFTER_DRAIN = false;
    const float* xp; const float* xs; float* X; const float* gate_l; int first;
    __device__ __forceinline__ void operator()(const f32x4 (&acc)[2][2][4][2], const Unit& u, int wr, int wc, int fr, int fq) const {
        const bool smp = u.pm >= 16;
        const int cb = smp ? ((u.pm - 16) >> 2) : 8;
        const int col0 = u.pn * BM + wc * 32 + 4 * fq;
        const float* gate = gate_l + (size_t)cb * NMOD + col0;
        f32x4 gv[2][2];
#pragma unroll
        for (int bj = 0; bj < 2; ++bj)
#pragma unroll
            for (int n = 0; n < 2; ++n) gv[bj][n] = *(const f32x4*)(gate + bj * HALF + n * 16);
        const int row0 = u.pm * BM + wr * 64 + fr;
        const float* sbase = first ? (smp ? xs + (size_t)(row0 - MP) * D : xp + (size_t)row0 * D) : X + (size_t)row0 * D;
        float* obase = X + (size_t)row0 * D;
#pragma unroll
        for (int ai = 0; ai < 2; ++ai)
#pragma unroll
            for (int m = 0; m < 4; ++m) {
                const size_t ro = (size_t)(ai * HALF + m * 16) * D + col0;
#pragma unroll
                for (int bj = 0; bj < 2; ++bj)
#pragma unroll
                    for (int n = 0; n < 2; ++n) { const f32x4 sv = *(const f32x4*)(sbase + ro + bj * HALF + n * 16); *(f32x4*)(obase + ro + bj * HALF + n * 16) = sv + gv[bj][n] * acc[ai][bj][m][n]; }
                if (m & 1) asm volatile("" ::: "memory");
            }
    }
};
struct EpiSwiglu {
    static constexpr bool PERM = true, AFTER_DRAIN = false;
    bf16_t* ACT;
    __device__ __forceinline__ void operator()(const f32x4 (&acc)[2][2][4][2], const Unit& u, int wr, int wc, int fr, int fq) const {
        bf16_t* base = ACT + (size_t)(u.pm * BM + wr * 64 + fr) * DFF + u.pn * HALF + wc * 32 + 8 * fq;
#pragma unroll
        for (int ai = 0; ai < 2; ++ai)
#pragma unroll
            for (int m = 0; m < 4; ++m) {
                const f32x4 g0 = acc[ai][0][m][0], g1 = acc[ai][0][m][1], u0 = acc[ai][1][m][0], u1 = acc[ai][1][m][1];
                u32x4 w;
                w.x = cvt_pk_bf16(fast_silu(g0[0]) * u0[0], fast_silu(g0[1]) * u0[1]); w.y = cvt_pk_bf16(fast_silu(g0[2]) * u0[2], fast_silu(g0[3]) * u0[3]);
                w.z = cvt_pk_bf16(fast_silu(g1[0]) * u1[0], fast_silu(g1[1]) * u1[1]); w.w = cvt_pk_bf16(fast_silu(g1[2]) * u1[2], fast_silu(g1[3]) * u1[3]);
                *(u32x4*)(base + (size_t)(ai * HALF + m * 16) * DFF) = w;
            }
    }
};

template <class Epi, class Sched, bool ALIGN_EPI = false, bool SP2 = false>
__device__ __forceinline__ void gemm_phase(PG8_LAS unsigned char* lds, const Gemm g, const Sched& S, const Epi& E) {
    const int tid = threadIdx.x, wid = __builtin_amdgcn_readfirstlane(tid >> 6), lane = tid & 63, wr = wid >> 2, wc = wid & 3, fr = lane & 15, fq = lane >> 4;
    const int K = g.K, nt = K / BK;
    unsigned voffA[2], voffB[2];
#pragma unroll
    for (int i = 0; i < 2; ++i) { int R, C; stage_rc(tid * 16 + i * 8192, R, C); const int Rb = Epi::PERM ? ((R & ~31) + perm32(R & 31)) : R;
        voffA[i] = (unsigned)(R * K + C) * 2u; voffB[i] = (unsigned)(Rb * K + C) * 2u; }
    const size_t kstep = (size_t)(BK * 2);
    const size_t hstep = (size_t)HALF * K * 2;
    const size_t tstep = 2 * hstep;
    const unsigned ldsw = (unsigned)wid * 1024u;
    const int aoff = lds_byte(wr * 64 + fr, fq * 8), boff = lds_byte(wc * 32 + fr, fq * 8);
#define PG8_SA(b, h) (((b) * 2 + (h)) * HTB)
#define PG8_SB(b, h) ((4 + (b) * 2 + (h)) * HTB)
#define PG8_STAGE(bufoff, gbase, voff) do { _Pragma("unroll") for (int _i = 0; _i < 2; ++_i) \
        __builtin_amdgcn_global_load_lds((const unsigned*)((const char*)(gbase) + (voff)[_i]), (PG8_LAS unsigned*)(lds + (bufoff) + ldsw + _i * 8192), 16, 0, 0); } while (0)
#define PG8_LDA(dst, b, h) do { _Pragma("unroll") for (int m = 0; m < 4; ++m) _Pragma("unroll") for (int k = 0; k < 2; ++k) dst[m][k] = *(const PG8_LAS bf16x8*)(lds + PG8_SA(b, h) + aoff + m * 2048 + k * 1024); } while (0)
#define PG8_LDB(dst, b, h) do { _Pragma("unroll") for (int n = 0; n < 2; ++n) _Pragma("unroll") for (int k = 0; k < 2; ++k) dst[n][k] = *(const PG8_LAS bf16x8*)(lds + PG8_SB(b, h) + boff + n * 2048 + k * 1024); } while (0)
#define PG8_MMA(ai, bj, At, Bt) do { __builtin_amdgcn_s_setprio(1); _Pragma("unroll") for (int m = 0; m < 4; ++m) _Pragma("unroll") for (int n = 0; n < 2; ++n) _Pragma("unroll") for (int k = 0; k < 2; ++k) \
        acc[ai][bj][m][n] = __builtin_amdgcn_mfma_f32_16x16x32_bf16(Bt[n][k], At[m][k], acc[ai][bj][m][n], 0, 0, 0); __builtin_amdgcn_s_setprio(0); } while (0)
#define PG8_WAIT_V(n) asm volatile("s_waitcnt vmcnt(" #n ")" ::: "memory")
#define PG8_WAIT_L(n) asm volatile("s_waitcnt lgkmcnt(" #n ")" ::: "memory")
#define PG8_BAR __builtin_amdgcn_s_barrier()
#define PG8_SCHED __builtin_amdgcn_sched_barrier(0)
    Unit cur, nxt; int ui = 0;
    if (!S.next(0, cur)) return;
    f32x4 acc[2][2][4][2];
#pragma unroll
    for (int a = 0; a < 2; ++a)
#pragma unroll
        for (int b = 0; b < 2; ++b)
#pragma unroll
            for (int m = 0; m < 4; ++m)
#pragma unroll
                for (int n = 0; n < 2; ++n) acc[a][b][m][n] = (f32x4){0.f, 0.f, 0.f, 0.f};
    bf16x8 At[4][2], B0[2][2], B1[2][2];
    const char* cA = (const char*)g.A + (size_t)cur.pm * tstep; const char* cB = (const char*)g.Bt + (size_t)cur.pn * tstep;
    S.a_ready(cur);
    if constexpr (SP2) {
        PG8_STAGE(PG8_SB(0, 0), cB, voffB); PG8_STAGE(PG8_SB(0, 1), cB + hstep, voffB); PG8_STAGE(PG8_SA(0, 0), cA, voffA); PG8_STAGE(PG8_SA(0, 1), cA + hstep, voffA);
        if (wr == 1) PG8_BAR;
        PG8_WAIT_V(2); PG8_BAR;
        PG8_STAGE(PG8_SB(1, 0), cB + kstep, voffB); PG8_STAGE(PG8_SA(1, 0), cA + kstep, voffA); PG8_STAGE(PG8_SB(1, 1), cB + hstep + kstep, voffB);
        PG8_WAIT_V(6); PG8_BAR;
    } else {
        PG8_STAGE(PG8_SB(0, 0), cB, voffB); PG8_STAGE(PG8_SA(0, 0), cA, voffA); PG8_STAGE(PG8_SB(0, 1), cB + hstep, voffB); PG8_STAGE(PG8_SA(0, 1), cA + hstep, voffA);
        if (wr == 1) PG8_BAR;
        PG8_WAIT_V(4); PG8_BAR;
        PG8_STAGE(PG8_SB(1, 0), cB + kstep, voffB); PG8_STAGE(PG8_SA(1, 0), cA + kstep, voffA); PG8_STAGE(PG8_SB(1, 1), cB + hstep + kstep, voffB);
        PG8_WAIT_V(6); PG8_BAR;
    }
    for (;;) {
        const bool has_next = S.next(ui + 1, nxt);
        const char* nA = has_next ? (const char*)g.A + (size_t)nxt.pm * tstep : cA; const char* nB = has_next ? (const char*)g.Bt + (size_t)nxt.pn * tstep : cB;
        for (int t = 0; t < nt; t += 2) {
            const bool last = (t == nt - 2);
            const char* a1 = cA + (size_t)(t + 1) * kstep;
            const char* a2 = last ? nA : cA + (size_t)(t + 2) * kstep; const char* b2 = last ? nB : cB + (size_t)(t + 2) * kstep;
            const char* a3 = a2 + kstep; const char* b3 = b2 + kstep;
            if (last && has_next) S.a_ready(nxt);
            if constexpr (SP2) {
            PG8_LDB(B0, 0, 0); PG8_LDB(B1, 0, 1); PG8_SCHED; PG8_LDA(At, 0, 0); PG8_STAGE(PG8_SA(1, 1), a1 + hstep, voffA);
            PG8_WAIT_V(8); PG8_WAIT_L(0); PG8_BAR; PG8_MMA(0, 0, At, B0); PG8_MMA(0, 1, At, B1); PG8_BAR; PG8_SCHED;
            PG8_LDA(At, 0, 1); PG8_STAGE(PG8_SB(0, 0), b2, voffB); PG8_STAGE(PG8_SB(0, 1), b2 + hstep, voffB); PG8_STAGE(PG8_SA(0, 0), a2, voffA);
            PG8_WAIT_V(8); PG8_WAIT_L(0); PG8_BAR; PG8_MMA(1, 0, At, B0); PG8_MMA(1, 1, At, B1); PG8_BAR; PG8_SCHED;
            PG8_LDB(B0, 1, 0); PG8_LDB(B1, 1, 1); PG8_SCHED; PG8_LDA(At, 1, 0); PG8_STAGE(PG8_SA(0, 1), a2 + hstep, voffA);
            PG8_WAIT_V(8); PG8_WAIT_L(0); PG8_BAR; PG8_MMA(0, 0, At, B0); PG8_MMA(0, 1, At, B1); PG8_BAR; PG8_SCHED;
            PG8_LDA(At, 1, 1); PG8_STAGE(PG8_SB(1, 0), b3, voffB); PG8_STAGE(PG8_SB(1, 1), b3 + hstep, voffB); PG8_STAGE(PG8_SA(1, 0), a3, voffA);
            PG8_WAIT_V(8); PG8_WAIT_L(0); PG8_BAR; PG8_MMA(1, 0, At, B0); PG8_MMA(1, 1, At, B1); PG8_BAR; PG8_SCHED;
            } else {
            PG8_LDB(B0, 0, 0); PG8_SCHED; PG8_LDA(At, 0, 0); PG8_STAGE(PG8_SA(1, 1), a1 + hstep, voffA);
            PG8_WAIT_L(8); PG8_BAR; PG8_WAIT_L(0); PG8_MMA(0, 0, At, B0); PG8_BAR; PG8_SCHED;
            PG8_LDB(B1, 0, 1); PG8_STAGE(PG8_SB(0, 0), b2, voffB);
            PG8_BAR; PG8_WAIT_L(0); PG8_MMA(0, 1, At, B1); PG8_BAR;
            PG8_LDA(At, 0, 1); PG8_STAGE(PG8_SA(0, 0), a2, voffA);
            PG8_BAR; PG8_WAIT_L(0); PG8_MMA(1, 0, At, B0); PG8_BAR; PG8_SCHED;
            PG8_STAGE(PG8_SB(0, 1), b2 + hstep, voffB);
            PG8_WAIT_V(6); PG8_BAR; PG8_MMA(1, 1, At, B1); PG8_BAR;
            PG8_LDB(B0, 1, 0); PG8_SCHED; PG8_LDA(At, 1, 0); PG8_STAGE(PG8_SA(0, 1), a2 + hstep, voffA);
            PG8_WAIT_L(8); PG8_BAR; PG8_WAIT_L(0); PG8_MMA(0, 0, At, B0); PG8_BAR; PG8_SCHED;
            PG8_LDB(B1, 1, 1); PG8_STAGE(PG8_SB(1, 0), b3, voffB);
            PG8_BAR; PG8_WAIT_L(0); PG8_MMA(0, 1, At, B1); PG8_BAR;
            PG8_LDA(At, 1, 1); PG8_STAGE(PG8_SA(1, 0), a3, voffA);
            PG8_BAR; PG8_WAIT_L(0); PG8_MMA(1, 0, At, B0); PG8_BAR; PG8_SCHED;
            PG8_STAGE(PG8_SB(1, 1), b3 + hstep, voffB);
            PG8_WAIT_V(6); PG8_BAR; PG8_MMA(1, 1, At, B1); PG8_BAR;
            }
        }
        if constexpr (ALIGN_EPI) { if (wr == 0) PG8_BAR; }
        if constexpr (!Epi::AFTER_DRAIN) { E(acc, cur, wr, wc, fr, fq); S.done(cur); }
        if (!has_next) break;
#pragma unroll
        for (int a = 0; a < 2; ++a)
#pragma unroll
            for (int b = 0; b < 2; ++b)
#pragma unroll
                for (int m = 0; m < 4; ++m)
#pragma unroll
                    for (int n = 0; n < 2; ++n) acc[a][b][m][n] = (f32x4){0.f, 0.f, 0.f, 0.f};
        cur = nxt; cA = nA; cB = nB; ++ui;
        if constexpr (ALIGN_EPI) { if (wr == 1) PG8_BAR; }
    }
    PG8_WAIT_V(0);
    if constexpr (!ALIGN_EPI) { if (wr == 0) PG8_BAR; }
    PG8_BAR;
    if constexpr (Epi::AFTER_DRAIN) { E.fused(acc, cur, wr, wc, fr, fq, lds, wid, lane); S.done(cur); }
#undef PG8_SA
#undef PG8_SB
#undef PG8_STAGE
#undef PG8_LDA
#undef PG8_LDB
#undef PG8_MMA
#undef PG8_WAIT_V
#undef PG8_WAIT_L
#undef PG8_BAR
#undef PG8_SCHED
}
}

namespace fa {
typedef short bf16x8 __attribute__((ext_vector_type(8)));
typedef float f32x16 __attribute__((ext_vector_type(16)));
constexpr int KROW = 272, VROW = 144, KT_BYTES = 64 * KROW, VT_BYTES = 128 * VROW, STAGE = KT_BYTES + VT_BYTES;
static_assert(2 * STAGE <= PHASE_LDS && 4 * 128 * 32 * 4 <= 2 * STAGE, "attention LDS map");
__device__ __forceinline__ unsigned cvt_pk(float lo, float hi) { unsigned r; asm volatile("v_cvt_pk_bf16_f32 %0, %1, %2" : "=v"(r) : "v"(lo), "v"(hi)); return r; }
__device__ __forceinline__ bf16x8 pack8(const f32x16& p, int b) {
    u32x4 w; w.x = cvt_pk(p[b + 0], p[b + 1]); w.y = cvt_pk(p[b + 2], p[b + 3]); w.z = cvt_pk(p[b + 4], p[b + 5]); w.w = cvt_pk(p[b + 6], p[b + 7]);
    return __builtin_bit_cast(bf16x8, w);
}
__device__ __forceinline__ void attn_unit(LAS unsigned char* lds, const bf16* Qg, const bf16* Kg, const bf16* Vg, const int Lk, bf16* MIXg, const float* subg, const float lam, const float post) {
    const int tid = threadIdx.x, lane = tid & 63, wid = __builtin_amdgcn_readfirstlane(tid >> 6), sm = wid & 1, qblk = wid >> 1, l31 = lane & 31, hh = lane >> 5;
    bf16x8 qf[4];
    { const bf16* qrow = Qg + (size_t)(qblk * 32 + l31) * 512 + sm * 64 + hh * 8;
#pragma unroll
      for (int ks = 0; ks < 4; ++ks) qf[ks] = *(const bf16x8*)(qrow + 16 * ks); }
    f32x16 o[4];
#pragma unroll
    for (int db = 0; db < 4; ++db)
#pragma unroll
        for (int r = 0; r < 16; ++r) o[db][r] = 0.f;
    float m_run = -1e30f, l_run = 0.f;
    const int nt = Lk >> 6;
    const int kr = tid >> 3, kc = tid & 7, vr = tid >> 2, vc = tid & 3;
    const bf16* kg = Kg + (size_t)kr * 512 + kc * 8;
    const bf16* vg = Vg + (size_t)vr * Lk + vc * 8;
    const int kw = kr * KROW + kc * 16, vw = KT_BYTES + vr * VROW + vc * 16;
    u32x4 sk0 = *(const u32x4*)(kg), sk1 = *(const u32x4*)(kg + 64), sv0 = *(const u32x4*)(vg), sv1 = *(const u32x4*)(vg + 32);
    *(LAS u32x4*)(lds + kw) = sk0; *(LAS u32x4*)(lds + kw + 128) = sk1; *(LAS u32x4*)(lds + vw) = sv0; *(LAS u32x4*)(lds + vw + 64) = sv1;
    __syncthreads();
    const int ka = l31 * KROW + (sm * 64 + hh * 8) * 2, va = KT_BYTES + l31 * VROW + hh * 16;
#pragma unroll 1
    for (int i = 0; i < nt; ++i) {
        LAS unsigned char* cur = lds + (i & 1) * STAGE;
        const bool more = (i + 1 < nt);
        if (more) { const bf16* k2 = kg + (size_t)(i + 1) * 64 * 512; const bf16* v2 = vg + (i + 1) * 64;
            sk0 = *(const u32x4*)(k2); sk1 = *(const u32x4*)(k2 + 64); sv0 = *(const u32x4*)(v2); sv1 = *(const u32x4*)(v2 + 32); }
        f32x16 s0, s1;
#pragma unroll
        for (int r = 0; r < 16; ++r) { s0[r] = 0.f; s1[r] = 0.f; }
#pragma unroll
        for (int ks = 0; ks < 4; ++ks) {
            const bf16x8 a0 = *(const LAS bf16x8*)(cur + ka + ks * 32), a1 = *(const LAS bf16x8*)(cur + ka + 32 * KROW + ks * 32);
            s0 = __builtin_amdgcn_mfma_f32_32x32x16_bf16(a0, qf[ks], s0, 0, 0, 0);
            s1 = __builtin_amdgcn_mfma_f32_32x32x16_bf16(a1, qf[ks], s1, 0, 0, 0);
        }
        float mx = fmaxf(s0[0], s1[0]);
#pragma unroll
        for (int r = 1; r < 16; ++r) mx = fmaxf(mx, fmaxf(s0[r], s1[r]));
        mx = fmaxf(mx, __shfl_xor(mx, 32));
        if (__any(mx > m_run)) {
            const float mn = fmaxf(m_run, mx), alpha = __builtin_amdgcn_exp2f(m_run - mn);
#pragma unroll
            for (int db = 0; db < 4; ++db)
#pragma unroll
                for (int r = 0; r < 16; ++r) o[db][r] *= alpha;
            l_run *= alpha; m_run = mn;
        }
        float ps = 0.f;
#pragma unroll
        for (int r = 0; r < 16; ++r) { s0[r] = __builtin_amdgcn_exp2f(s0[r] - m_run); s1[r] = __builtin_amdgcn_exp2f(s1[r] - m_run); ps += s0[r] + s1[r]; }
        l_run += ps;
        bf16x8 pf[4];
        pf[0] = pack8(s0, 0); pf[1] = pack8(s0, 8); pf[2] = pack8(s1, 0); pf[3] = pack8(s1, 8);
#pragma unroll
        for (int db = 0; db < 4; ++db)
#pragma unroll
            for (int st = 0; st < 4; ++st) {
                const bf16x8 a = *(const LAS bf16x8*)(cur + va + db * 32 * VROW + st * 32);
                o[db] = __builtin_amdgcn_mfma_f32_32x32x16_bf16(a, pf[st], o[db], 0, 0, 0);
            }
        if (more) { LAS unsigned char* nx = lds + ((i + 1) & 1) * STAGE;
            *(LAS u32x4*)(nx + kw) = sk0; *(LAS u32x4*)(nx + kw + 128) = sk1; *(LAS u32x4*)(nx + vw) = sv0; *(LAS u32x4*)(nx + vw + 64) = sv1; }
        __syncthreads();
    }
    const float ltot = l_run + __shfl_xor(l_run, 32);
    LAS float* X = (LAS float*)lds + qblk * 128 * 32;
    if (sm == 1) {
        const float sc = lam / ltot;
#pragma unroll
        for (int db = 0; db < 4; ++db)
#pragma unroll
            for (int r = 0; r < 16; ++r) X[(32 * db + (r & 3) + 8 * (r >> 2) + 4 * hh) * 32 + l31] = o[db][r] * sc;
    }
    __syncthreads();
    if (sm == 0) {
        const float sc = 1.0f / ltot; float ss = 0.f;
#pragma unroll
        for (int db = 0; db < 4; ++db)
#pragma unroll
            for (int r = 0; r < 16; ++r) { const float v = o[db][r] * sc - X[(32 * db + (r & 3) + 8 * (r >> 2) + 4 * hh) * 32 + l31]; o[db][r] = v; ss += v * v; }
        ss += __shfl_xor(ss, 32);
        const float rs = post / sqrtf(ss * (1.0f / 128.0f) + EPS);
        bf16* orow = MIXg + (size_t)(qblk * 32 + l31) * D + 4 * hh;
#pragma unroll
        for (int db = 0; db < 4; ++db)
#pragma unroll
            for (int g4 = 0; g4 < 4; ++g4) {
                const int d = 32 * db + 8 * g4;
                const f32x4 gv = *(const f32x4*)(subg + d + 4 * hh);
                const unsigned w0 = cvt_pk(o[db][4 * g4 + 0] * rs * gv.x, o[db][4 * g4 + 1] * rs * gv.y), w1 = cvt_pk(o[db][4 * g4 + 2] * rs * gv.z, o[db][4 * g4 + 3] * rs * gv.w);
                *(u32x2*)(orow + d) = (u32x2){w0, w1};
            }
    }
    __syncthreads();
}
}
namespace mx {
typedef short bf16x8 __attribute__((ext_vector_type(8)));
typedef float f32x16 __attribute__((ext_vector_type(16)));
__device__ __forceinline__ unsigned cvt_pk(float lo, float hi) { unsigned r; asm volatile("v_cvt_pk_bf16_f32 %0, %1, %2" : "=v"(r) : "v"(lo), "v"(hi)); return r; }
__device__ __forceinline__ bf16x8 pack8f(const f32x4 a, const f32x4 b) { u32x4 w; w.x = cvt_pk(a.x, a.y); w.y = cvt_pk(a.z, a.w); w.z = cvt_pk(b.x, b.y); w.w = cvt_pk(b.z, b.w); return __builtin_bit_cast(bf16x8, w); }
constexpr int VROW = 272;
__device__ __forceinline__ void sgu_unit(const Args& a, Frame& F, const int chunk, const int g, const float* gn, const float* wsg, const float* bsg) {
    LAS unsigned char* vt = F.lds;
    const bf16* VG = (const bf16*)(a.ws + WS_VG); const bf16* U = (const bf16*)(a.ws + WS_U); bf16* MIX = (bf16*)(a.ws + WS_MIX);
    const int m0 = chunk * 128, lane = F.lane, l31 = lane & 31, hh = lane >> 5;
    const f32x4 g4 = *(const f32x4*)(gn + 64 * g + 4 * (lane & 15));
#pragma unroll 4
    for (int i = 0; i < 16; ++i) {
        const int q = 16 * F.wave + i;
        const u32x2 w = *(const u32x2*)(VG + (size_t)(m0 + q) * 256 + 4 * lane);
        const float x0 = bflo(w.x), x1 = bfhi(w.x), x2 = bflo(w.y), x3 = bfhi(w.y);
        const float mean = wave_sum((x0 + x1) + (x2 + x3)) * (1.0f / 256.0f);
        const float d0 = x0 - mean, d1 = x1 - mean, d2 = x2 - mean, d3 = x3 - mean;
        const float var = wave_sum((d0 * d0 + d1 * d1) + (d2 * d2 + d3 * d3)) * (1.0f / 256.0f);
        const float r = 1.0f / sqrtf(var + EPS);
        if ((lane >> 4) == g) {
            const int c = 4 * (lane & 15);
            LAS bf16* dst = (LAS bf16*)(vt + c * VROW) + q;
            dst[0] = (bf16)f2bf(d0 * r * g4.x); dst[VROW / 2] = (bf16)f2bf(d1 * r * g4.y); dst[VROW] = (bf16)f2bf(d2 * r * g4.z); dst[3 * VROW / 2] = (bf16)f2bf(d3 * r * g4.w);
        }
    }
    __syncthreads();
    const int cb = F.wave & 1, pb = F.wave >> 1, p = 32 * pb + l31;
    f32x16 acc;
#pragma unroll
    for (int r = 0; r < 16; ++r) acc[r] = 0.f;
    const float* wrow = wsg + ((size_t)g * 128 + p) * 128 + 8 * hh;
    const LAS unsigned char* arow = vt + (32 * cb + l31) * VROW + 16 * hh;
#pragma unroll
    for (int ks = 0; ks < 8; ++ks) {
        const bf16x8 A = *(const LAS bf16x8*)(arow + 32 * ks);
        const bf16x8 B = pack8f(*(const f32x4*)(wrow + 16 * ks), *(const f32x4*)(wrow + 16 * ks + 4));
        acc = __builtin_amdgcn_mfma_f32_32x32x16_bf16(A, B, acc, 0, 0, 0);
    }
    const float bias = bsg[g * 128 + p];
    const bf16* urow = U + (size_t)(m0 + p) * 256 + 64 * g + 32 * cb + 4 * hh;
    bf16* orow = MIX + (size_t)(m0 + p) * D + 768 + 64 * g + 32 * cb + 4 * hh;
#pragma unroll
    for (int q4 = 0; q4 < 4; ++q4) {
        const u32x2 uw = *(const u32x2*)(urow + 8 * q4);
        const unsigned w0 = cvt_pk(bflo(uw.x) * (acc[4 * q4 + 0] + bias), bfhi(uw.x) * (acc[4 * q4 + 1] + bias));
        const unsigned w1 = cvt_pk(bflo(uw.y) * (acc[4 * q4 + 2] + bias), bfhi(uw.y) * (acc[4 * q4 + 3] + bias));
        *(u32x2*)(orow + 8 * q4) = (u32x2){w0, w1};
    }
    __syncthreads();
}
constexpr int QROW = 528;
__device__ __forceinline__ void pool_unit(const Args& a, Frame& F, const int unit, const bf16x8 (&bw)[4], const float ps) {
    LAS float* P = (LAS float*)F.lds;
    LAS unsigned char* Qb = F.lds + 48 * 256 * 4;
    const bf16* PP = (const bf16*)(a.ws + WS_PP); bf16* MIX = (bf16*)(a.ws + WS_MIX);
    const int m0 = unit * 32;
    const bool smp = m0 >= MP;
    const int L = smp ? LS : LP;
    const int t0 = smp ? ((m0 - MP) & 1023) : (m0 & 255);
    const int mseq = m0 - t0;
#pragma unroll 2
    for (int i = F.tid; i < 48 * 64; i += NTHREADS) {
        const int r = i >> 6, c4 = (i & 63) * 4, t = t0 - 8 + r;
        f32x4 v = {0.f, 0.f, 0.f, 0.f};
        if (t >= 0 && t < L) { const u32x2 w = *(const u32x2*)(PP + (size_t)(mseq + t) * 256 + c4); v = (f32x4){bflo(w.x), bfhi(w.x), bflo(w.y), bfhi(w.y)}; }
        *(LAS f32x4*)(P + r * 256 + c4) = v;
    }
    __syncthreads();
#pragma unroll 1
    for (int i = F.tid; i < 32 * 256; i += NTHREADS) {
        const int tt = i >> 8, c = i & 255, hw = 1 << (c >> 6);
        const int t = t0 + tt;
        int lo = t - hw; if (lo < 0) lo = 0;
        int hi = t + hw; if (hi > L) hi = L;
        float sacc = 0.f;
#pragma unroll 1
        for (int u = lo; u < hi; ++u) sacc += P[(u - t0 + 8) * 256 + c];
        *((LAS bf16*)(Qb + tt * QROW) + c) = (bf16)f2bf(sacc / (float)(hi - lo) - P[(tt + 8) * 256 + c]);
    }
    __syncthreads();
    const int g = F.wave >> 1, dblk = F.wave & 1, l31 = F.lane & 31, hh = F.lane >> 5;
    f32x16 acc;
#pragma unroll
    for (int r = 0; r < 16; ++r) acc[r] = 0.f;
#pragma unroll
    for (int ks = 0; ks < 4; ++ks) {
        const bf16x8 A = *(const LAS bf16x8*)(Qb + l31 * QROW + (64 * g + 16 * ks + 8 * hh) * 2);
        acc = __builtin_amdgcn_mfma_f32_32x32x16_bf16(A, bw[ks], acc, 0, 0, 0);
    }
    bf16* o = MIX + (size_t)m0 * D + 64 * g + 32 * dblk + l31;
#pragma unroll
    for (int r = 0; r < 16; ++r) o[(size_t)((r & 3) + 8 * (r >> 2) + 4 * hh) * D] = (bf16)f2bf(acc[r] * ps);
    __syncthreads();
}
}
__device__ __forceinline__ void mixer_phase(const Args& a, Frame& F, int l) {
    const int G = gridDim.x, c = blockIdx.x;
    const int v = (G % 8 == 0) ? (c % 8) * (G / 8) + c / 8 : c;
    const float lam = ((const float*)(a.ws + WS_LAM))[l];
    const float post = 1.0f - ((l == 0) ? 0.2f : (float)(0.8 - 0.6 * 0.7408182206817179));
    const float* subg = inp(F, 16) + l * 128;
    const bf16* Q = (const bf16*)(a.ws + WS_Q); bf16* MIX = (bf16*)(a.ws + WS_MIX);
#pragma unroll 1
    for (int u = v; u < 256; u += G) {
        const int bh = u >> 3, qb = u & 7, b = bh >> 2, h = bh & 3, m0 = MP + b * LS + qb * 128;
        fa::attn_unit(F.lds, Q + (size_t)m0 * 512 + h * 128, (const bf16*)(a.ws + WS_KS) + (size_t)b * LKS * 512 + h * 128, (const bf16*)(a.ws + WS_VTS) + (size_t)(b * 4 + h) * 128 * LKS, LKS,
                      MIX + (size_t)m0 * D + 256 + h * 128, subg, lam, post);
    }
    const bool g256 = (G == 256);
    int a_lo = v, a_hi = 128, a_st = G, s_lo = v, s_hi = 384, s_st = G, p_lo = v, p_hi = 384, p_st = G;
    if (g256) {
        if (v < 128) { a_lo = v; a_hi = v + 1; s_lo = v; s_hi = v + 1; p_lo = 0; p_hi = 0; }
        else { a_lo = 0; a_hi = 0; s_lo = 128 + 2 * (v - 128); s_hi = s_lo + 2; p_lo = 3 * (v - 128); p_hi = p_lo + 3; }
        a_st = 1; s_st = 1; p_st = 1;
    }
#pragma unroll 1
    for (int u = a_lo; u < a_hi; u += a_st) {
        const int bh = u >> 1, qb = u & 1, b = bh >> 2, h = bh & 3, m0 = b * LP + qb * 128;
        fa::attn_unit(F.lds, Q + (size_t)m0 * 512 + h * 128, (const bf16*)(a.ws + WS_KP) + (size_t)b * LP * 512 + h * 128, (const bf16*)(a.ws + WS_VTP) + (size_t)(b * 4 + h) * 128 * LP, LP,
                      MIX + (size_t)m0 * D + 256 + h * 128, subg, lam, post);
    }
    {
        const float* gn = inp(F, 17) + l * 256; const float* wsg = inp(F, 18) + (size_t)l * 4 * 128 * 128; const float* bsg = inp(F, 19) + l * 4 * 128;
#pragma unroll 1
        for (int u = s_lo; u < s_hi; u += s_st) mx::sgu_unit(a, F, u >> 2, u & 3, gn, wsg, bsg);
    }
    if (p_lo < p_hi) {
        const int g = F.wave >> 1, dblk = F.wave & 1, l31 = F.lane & 31, hh = F.lane >> 5;
        const float* wp = inp(F, 10) + (size_t)l * 4 * 64 * 64 + (size_t)g * 4096 + 32 * dblk + l31;
        mx::bf16x8 bw[4];
#pragma unroll
        for (int ks = 0; ks < 4; ++ks) {
            const float* q = wp + (size_t)(16 * ks + 8 * hh) * 64;
            bw[ks] = mx::pack8f((f32x4){q[0], q[64], q[128], q[192]}, (f32x4){q[256], q[320], q[384], q[448]});
        }
        const float ps = (inp(F, 11) + l * 256)[64 * g + 32 * dblk + l31];
#pragma unroll 1
        for (int u = p_lo; u < p_hi; u += p_st) mx::pool_unit(a, F, u, bw, ps);
    }
}

__device__ __forceinline__ void attn_ref(const Args& a, Frame& F, int l) {
    LAS float* wq = (LAS float*)F.lds + F.wave * (128 + 3 * LKS);
    LAS float* ws1 = wq + 128;
    LAS float* ws2 = ws1 + LKS;
    LAS float* wp = ws2 + LKS;
    const bf16* Q = (const bf16*)(a.ws + WS_Q);
    bf16* MIX = (bf16*)(a.ws + WS_MIX);
    const float lam = ((const float*)(a.ws + WS_LAM))[l];
    const float lam_init = (l == 0) ? 0.2f : (float)(0.8 - 0.6 * 0.7408182206817179);
    const float* subg = inp(F, 16) + l * 128;
    const int gw = blockIdx.x * NWAVES + F.wave, NGW = gridDim.x * NWAVES;
#pragma unroll 1
    for (int it = gw; it < M * 4; it += NGW) {
        const int m = it >> 2, h = it & 3;
        const bool smp = m >= MP;
        const int b = smp ? ((m - MP) >> 10) : (m >> 8);
        const int Lk = smp ? LKS : LP, nk = Lk >> 6;
        const bf16* Kb = smp ? (const bf16*)(a.ws + WS_KS) + (size_t)b * LKS * 512 + h * 128 : (const bf16*)(a.ws + WS_KP) + (size_t)b * LP * 512 + h * 128;
        const bf16* Vb = smp ? (const bf16*)(a.ws + WS_VTS) + (size_t)(b * 4 + h) * 128 * LKS : (const bf16*)(a.ws + WS_VTP) + (size_t)(b * 4 + h) * 128 * LP;
        wq[F.lane] = bf2f(Q[(size_t)m * 512 + h * 128 + F.lane]); wq[64 + F.lane] = bf2f(Q[(size_t)m * 512 + h * 128 + 64 + F.lane]);
        asm volatile("s_waitcnt lgkmcnt(0)" ::: "memory");
        float m1 = -1e30f, m2 = -1e30f;
#pragma unroll 1
        for (int kk = 0; kk < nk; ++kk) {
            const u32x4* kr = (const u32x4*)(Kb + (size_t)(kk * 64 + F.lane) * 512);
            float d1 = 0.f, d2 = 0.f;
#pragma unroll
            for (int c = 0; c < 8; ++c) {
                const u32x4 k1 = kr[c], k2 = kr[8 + c];
                const f32x4 qa = *(const LAS f32x4*)(wq + 8 * c), qb = *(const LAS f32x4*)(wq + 8 * c + 4);
                const f32x4 qc = *(const LAS f32x4*)(wq + 64 + 8 * c), qd = *(const LAS f32x4*)(wq + 64 + 8 * c + 4);
                d1 += qa.x * bflo(k1.x) + qa.y * bfhi(k1.x) + qa.z * bflo(k1.y) + qa.w * bfhi(k1.y) + qb.x * bflo(k1.z) + qb.y * bfhi(k1.z) + qb.z * bflo(k1.w) + qb.w * bfhi(k1.w);
                d2 += qc.x * bflo(k2.x) + qc.y * bfhi(k2.x) + qc.z * bflo(k2.y) + qc.w * bfhi(k2.y) + qd.x * bflo(k2.z) + qd.y * bfhi(k2.z) + qd.z * bflo(k2.w) + qd.w * bfhi(k2.w);
            }
            ws1[kk * 64 + F.lane] = d1; ws2[kk * 64 + F.lane] = d2;
            m1 = fmaxf(m1, d1); m2 = fmaxf(m2, d2);
        }
        m1 = wave_max(m1); m2 = wave_max(m2);
        asm volatile("s_waitcnt lgkmcnt(0)" ::: "memory");
        float l1 = 0.f, l2 = 0.f;
#pragma unroll 1
        for (int kk = 0; kk < nk; ++kk) {
            const float e1 = exp2f(ws1[kk * 64 + F.lane] - m1), e2 = exp2f(ws2[kk * 64 + F.lane] - m2);
            ws1[kk * 64 + F.lane] = e1; ws2[kk * 64 + F.lane] = e2; l1 += e1; l2 += e2;
        }
        l1 = wave_sum(l1); l2 = wave_sum(l2);
        const float i1 = 1.0f / l1, i2 = lam / l2;
        asm volatile("s_waitcnt lgkmcnt(0)" ::: "memory");
#pragma unroll 1
        for (int kk = 0; kk < nk; ++kk) wp[perm16(kk * 64 + F.lane)] = ws1[kk * 64 + F.lane] * i1 - ws2[kk * 64 + F.lane] * i2;
        asm volatile("s_waitcnt lgkmcnt(0)" ::: "memory");
        float o0 = 0.f, o1 = 0.f;
        const bf16* v0 = Vb + (size_t)F.lane * Lk; const bf16* v1 = Vb + (size_t)(64 + F.lane) * Lk;
#pragma unroll 2
        for (int p = 0; p < Lk; p += 8) {
            const u32x4 a0 = *(const u32x4*)(v0 + p), a1 = *(const u32x4*)(v1 + p);
            const f32x4 pa = *(const LAS f32x4*)(wp + p), pb = *(const LAS f32x4*)(wp + p + 4);
            o0 += pa.x * bflo(a0.x) + pa.y * bfhi(a0.x) + pa.z * bflo(a0.y) + pa.w * bfhi(a0.y) + pb.x * bflo(a0.z) + pb.y * bfhi(a0.z) + pb.z * bflo(a0.w) + pb.w * bfhi(a0.w);
            o1 += pa.x * bflo(a1.x) + pa.y * bfhi(a1.x) + pa.z * bflo(a1.y) + pa.w * bfhi(a1.y) + pb.x * bflo(a1.z) + pb.y * bfhi(a1.z) + pb.z * bflo(a1.w) + pb.w * bfhi(a1.w);
        }
        const float ss = wave_sum(o0 * o0 + o1 * o1);
        const float r = (1.0f / sqrtf(ss * (1.0f / 128.0f) + EPS)) * (1.0f - lam_init);
        MIX[(size_t)m * D + 256 + h * 128 + F.lane] = (bf16)f2bf(o0 * r * subg[F.lane]);
        MIX[(size_t)m * D + 256 + h * 128 + 64 + F.lane] = (bf16)f2bf(o1 * r * subg[64 + F.lane]);
        asm volatile("s_waitcnt lgkmcnt(0)" ::: "memory");
    }
}
__device__ __forceinline__ void pool_phase(const Args& a, Frame& F, int l) {
    LAS float* P = (LAS float*)F.lds;
    LAS float* Qp = P + 48 * 256;
    LAS float* Wl = Qp + 32 * 256;
    const bf16* PP = (const bf16*)(a.ws + WS_PP);
    bf16* MIX = (bf16*)(a.ws + WS_MIX);
    const float* wpool = inp(F, 10) + (size_t)l * 4 * 64 * 64; const float* pscale = inp(F, 11) + l * 256;
    bool have = false;
#pragma unroll 1
    for (int unit = blockIdx.x; unit < M / 32; unit += gridDim.x) {
        const int m0 = unit * 32;
        const bool smp = m0 >= MP;
        const int L = smp ? LS : LP;
        const int t0 = smp ? ((m0 - MP) & 1023) : (m0 & 255);
        const int mseq = m0 - t0;
        __syncthreads();
        if (!have) { for (int i = F.tid; i < 4 * 64 * 64 / 4; i += NTHREADS) *(LAS f32x4*)(Wl + 4 * i) = *(const f32x4*)(wpool + 4 * i); have = true; }
#pragma unroll 1
        for (int i = F.tid; i < 48 * 64; i += NTHREADS) {
            const int r = i >> 6, c4 = (i & 63) * 4, t = t0 - 8 + r;
            f32x4 v = {0.f, 0.f, 0.f, 0.f};
            if (t >= 0 && t < L) { const u32x2 w = *(const u32x2*)(PP + (size_t)(mseq + t) * 256 + c4); v = (f32x4){bflo(w.x), bfhi(w.x), bflo(w.y), bfhi(w.y)}; }
            *(LAS f32x4*)(P + r * 256 + c4) = v;
        }
        __syncthreads();
#pragma unroll 1
        for (int i = F.tid; i < 32 * 256; i += NTHREADS) {
            const int tt = i >> 8, c = i & 255, g = c >> 6, hw = 1 << g;
            const int t = t0 + tt;
            int lo = t - hw; if (lo < 0) lo = 0;
            int hi = t + hw; if (hi > L) hi = L;
            float s = 0.f;
#pragma unroll 1
            for (int u = lo; u < hi; ++u) s += P[(u - t0 + 8) * 256 + c];
            Qp[tt * 256 + c] = s / (float)(hi - lo) - P[(tt + 8) * 256 + c];
        }
        __syncthreads();
        {
            const int d = F.tid & 63, g = (F.tid >> 6) & 3, half = F.tid >> 8;
            const float ps = pscale[g * 64 + d];
            const LAS float* wg = Wl + g * 4096 + d;
#pragma unroll 1
            for (int tt = half * 16; tt < half * 16 + 16; ++tt) {
                float acc = 0.f;
#pragma unroll 4
                for (int c = 0; c < 64; c += 4) { const f32x4 q = *(const LAS f32x4*)(Qp + tt * 256 + g * 64 + c);
                    acc += q.x * wg[(c + 0) * 64] + q.y * wg[(c + 1) * 64] + q.z * wg[(c + 2) * 64] + q.w * wg[(c + 3) * 64]; }
                MIX[(size_t)(m0 + tt) * D + g * 64 + d] = (bf16)f2bf(acc * ps);
            }
        }
    }
    __syncthreads();
}
__device__ __forceinline__ void sgu_ref(const Args& a, Frame& F, int l) {
    LAS float* vn = (LAS float*)F.lds;
    const bf16* VG = (const bf16*)(a.ws + WS_VG); const bf16* U = (const bf16*)(a.ws + WS_U);
    bf16* MIX = (bf16*)(a.ws + WS_MIX);
    const float* gn = inp(F, 17) + l * 256; const float* wsg = inp(F, 18) + (size_t)l * 4 * 128 * 128; const float* bsg = inp(F, 19) + l * 4 * 128;
    for (int unit = blockIdx.x; unit < M / 128; unit += gridDim.x) {
        const int m0 = unit * 128;
        __syncthreads();
        for (int q = F.wave; q < 128; q += NWAVES) {
            const u32x2 w = *(const u32x2*)(VG + (size_t)(m0 + q) * 256 + 4 * F.lane);
            const float x0 = bflo(w.x), x1 = bfhi(w.x), x2 = bflo(w.y), x3 = bfhi(w.y);
            const float mean = wave_sum((x0 + x1) + (x2 + x3)) * (1.0f / 256.0f);
            const float d0 = x0 - mean, d1 = x1 - mean, d2 = x2 - mean, d3 = x3 - mean;
            const float var = wave_sum((d0 * d0 + d1 * d1) + (d2 * d2 + d3 * d3)) * (1.0f / 256.0f);
            const float r = 1.0f / sqrtf(var + EPS);
            const f32x4 g4 = *(const f32x4*)(gn + 4 * F.lane);
            *(LAS f32x4*)(vn + q * 256 + 4 * F.lane) = (f32x4){d0 * r * g4.x, d1 * r * g4.y, d2 * r * g4.z, d3 * r * g4.w};
        }
        __syncthreads();
        const int c = F.tid & 255, ph = F.tid >> 8, g = c >> 6;
        for (int p = ph * 64; p < ph * 64 + 64; ++p) {
            const float* wr = wsg + ((size_t)g * 128 + p) * 128;
            float acc = bsg[g * 128 + p];
#pragma unroll 8
            for (int q = 0; q < 128; ++q) acc += wr[q] * vn[q * 256 + c];
            const float u = bf2f(U[(size_t)(m0 + p) * 256 + c]);
            MIX[(size_t)(m0 + p) * D + 768 + c] = (bf16)f2bf(u * acc);
        }
    }
    __syncthreads();
}
__device__ __forceinline__ void final_phase(const Args& a, Frame& F) {
    const float* g = inp(F, 24);
    const int gw = blockIdx.x * NWAVES + F.wave, NGW = gridDim.x * NWAVES;
    for (int m = gw; m < M; m += NGW) {
        f32x4* xr = (f32x4*)(a.out + (size_t)m * D) + F.lane;
        f32x4 v[4]; float s = 0.f;
#pragma unroll
        for (int j = 0; j < 4; ++j) { v[j] = xr[64 * j]; s += (v[j].x * v[j].x + v[j].y * v[j].y) + (v[j].z * v[j].z + v[j].w * v[j].w); }
        const float rstd = 1.0f / sqrtf(wave_sum(s) * (1.0f / D) + EPS);
#pragma unroll
        for (int j = 0; j < 4; ++j) { const f32x4 gv = *(const f32x4*)(g + 4 * (64 * j + F.lane)); xr[64 * j] = (f32x4){v[j].x * rstd * gv.x, v[j].y * rstd * gv.y, v[j].z * rstd * gv.z, v[j].w * rstd * gv.w}; }
    }
}

#define XB_TMO      128
#define XB_XCNT(j)  (256  + 64 * (j))
#define XB_XSUB(j)  (1280 + 64 * (j))
#define XB_XGEN(j)  (2304 + 64 * (j))
#define XB_TOP      3328
#define XB_TOPGEN   3392
#define XCD_BAR_WORDS 3456
#define XB_SPIN_CAP (1u << 20)
__device__ __forceinline__ unsigned xb_ld(unsigned* p)              { return __hip_atomic_load(p, __ATOMIC_RELAXED, __HIP_MEMORY_SCOPE_AGENT); }
__device__ __forceinline__ unsigned xb_add(unsigned* p, unsigned v) { return __hip_atomic_fetch_add(p, v, __ATOMIC_RELAXED, __HIP_MEMORY_SCOPE_AGENT); }
__device__ __forceinline__ unsigned xb_xcc_id() { return (unsigned)__builtin_amdgcn_s_getreg((3 << 11) | 20) & 0xFu; }
#define XB_SPIN(cond, bar) do { unsigned _sp = 0; while (cond) { __builtin_amdgcn_s_sleep(1); \
    if ((++_sp & 255u) == 0u) { if (xb_ld(&(bar)[XB_TMO])) break; if (_sp > XB_SPIN_CAP) { atomicAdd(&(bar)[XB_TMO], 1u); break; } } } } while (0)
struct XcdBarrier { unsigned* bar; unsigned x; volatile LAS unsigned* st; };
__device__ __forceinline__ XcdBarrier xcd_barrier_post(unsigned* bar, volatile LAS unsigned* st) {
    XcdBarrier b; b.bar = bar; b.x = xb_xcc_id(); b.st = st;
    if (threadIdx.x == 0) (void)xb_add(&bar[XB_XCNT(b.x)], 1u);
    return b;
}
__device__ __forceinline__ void xcd_barrier_complete(unsigned* bar, unsigned x, unsigned& nloc, unsigned& nx) {
    const unsigned G = gridDim.x * gridDim.y * gridDim.z;
    unsigned sum, cnt, mine, sp = 0u;
    for (;;) {
        sum = 0u; cnt = 0u; mine = 0u;
#pragma unroll
        for (unsigned j = 0; j < 16; ++j) { const unsigned c = xb_ld(&bar[XB_XCNT(j)]); sum += c; cnt += (c > 0u) ? 1u : 0u; mine = (j == x) ? c : mine; }
        if (sum == G) break;
        __builtin_amdgcn_s_sleep(1);
        if ((++sp & 255u) == 0u) { if (xb_ld(&bar[XB_TMO])) break; if (sp > XB_SPIN_CAP) { atomicAdd(&bar[XB_TMO], 1u); break; } }
    }
    nloc = mine > 0u ? mine : 1u; nx = cnt > 0u ? cnt : 1u;
}
__device__ __forceinline__ void xcd_barrier(const XcdBarrier& b) {
    asm volatile("s_waitcnt vmcnt(0)" ::: "memory");
    __syncthreads();
    if (threadIdx.x == 0) {
        unsigned* bar = b.bar;
        __builtin_amdgcn_s_waitcnt(0);
        unsigned nloc = b.st[0], nx = b.st[1];
        if (nloc == 0u) { xcd_barrier_complete(bar, b.x, nloc, nx); b.st[0] = nloc; b.st[1] = nx; }
        const unsigned old = xb_add(&bar[XB_XSUB(b.x)], 1u);
        const unsigned gen = old / nloc;
        if (old + 1u == (gen + 1u) * nloc) {
            __builtin_amdgcn_fence(__ATOMIC_RELEASE, "agent");
            asm volatile("s_waitcnt vmcnt(0)" ::: "memory");
            const unsigned og = xb_add(&bar[XB_TOP], 1u);
            const unsigned tg = og / nx;
            if (og + 1u == (tg + 1u) * nx) xb_add(&bar[XB_TOPGEN], 1u);
            else XB_SPIN(xb_ld(&bar[XB_TOPGEN]) == tg, bar);
            __builtin_amdgcn_fence(__ATOMIC_ACQUIRE, "agent");
            xb_add(&bar[XB_XGEN(b.x)], 1u);
            asm volatile("s_waitcnt vmcnt(0)" ::: "memory");
        } else {
            XB_SPIN(xb_ld(&bar[XB_XGEN(b.x)]) == gen, bar);
            __builtin_amdgcn_fence(__ATOMIC_ACQUIRE, "agent");
            asm volatile("s_waitcnt vmcnt(0)" ::: "memory");
        }
    }
    __syncthreads();
}

constexpr int NPHASES = 16;
#ifndef REP_P0
#define REP_P0 1
#endif
#ifndef REP_NORM1
#define REP_NORM1 1
#endif
#ifndef REP_INPROJ
#define REP_INPROJ 1
#endif
#ifndef REP_MIX
#define REP_MIX 1
#endif
#ifndef REP_NORM2
#define REP_NORM2 1
#endif
#ifndef REP_FFN1
#define REP_FFN1 1
#endif
#ifndef REF_MIX
#define REF_MIX 0
#endif
#ifndef REF_GEMM
#define REF_GEMM 0
#endif
#ifndef PHMASK
#define PHMASK 0xFFFF
#endif
#define PHM(k) ((PHMASK >> (k)) & 1)
template <int l>
__device__ __forceinline__ void layer_phases(const Args& args, Frame& F, const XcdBarrier& bar, const int lo, const int hi) {
    constexpr int pb = 1 + 7 * l;
#define IN(k) (lo <= (k) && (k) < hi)
#define SEAM(k) do { if (N_LAUNCHES == 1 && IN(k) && IN((k) + 1)) xcd_barrier(bar); } while (0)

        if (IN(pb + 0)) for (int rep = 0; rep < REP_NORM1; ++rep) { if (PHM(1)) { norm_phase(args, F, l, 0); cache_phase(args, F, l); } }
        SEAM(pb + 0);
        if (IN(pb + 1)) for (int rep = 0; rep < REP_INPROJ; ++rep) { if (PHM(2)) {
#if REF_GEMM
            RefEpiIn E{&args, l}; ref_gemm<16, RefEpiIn>(F.lds, (const bf16*)(args.ws + WS_H), (const bf16*)(args.ws + WS_WIN) + (size_t)l * NIN * D, M, NIN, D, E);
#else
            pg8::Gemm g{(const bf16*)(args.ws + WS_H), (const bf16*)(args.ws + WS_WIN) + (size_t)l * NIN * D, M, NIN, D}; pg8::StaticOrder S; S.init(M, NIN, (int)gridDim.x, (int)blockIdx.x);
            pg8::EpiIn E{args.ws, args.out, l}; pg8::gemm_phase<pg8::EpiIn, pg8::StaticOrder, true, true>(F.lds, g, S, E);
#endif
        } }
        SEAM(pb + 1);
        if (IN(pb + 2)) for (int rep = 0; rep < REP_MIX; ++rep) {
#if REF_MIX
            attn_ref(args, F, l); __syncthreads(); pool_phase(args, F, l); sgu_ref(args, F, l);
#else
            mixer_phase(args, F, l);
#endif
        }
        SEAM(pb + 2);
        if (IN(pb + 3)) { if (PHM(4)) {
#if REF_GEMM
            RefEpiRes E{&args, &F, l, 2, l == 0 ? 1 : 0}; ref_gemm<16, RefEpiRes>(F.lds, (const bf16*)(args.ws + WS_MIX), (const bf16*)(args.ws + WS_WOUT) + (size_t)l * D * D, M, D, D, E);
#else
            pg8::Gemm g{(const bf16*)(args.ws + WS_MIX), (const bf16*)(args.ws + WS_WOUT) + (size_t)l * D * D, M, D, D}; pg8::StaticOrder S; S.init(M, D, (int)gridDim.x, (int)blockIdx.x);
            pg8::EpiRes E{inp(F, 0), inp(F, 1), args.out, (const float*)(args.ws + WS_MOD) + (size_t)l * NCOND * NMOD + 2 * D, l == 0 ? 1 : 0};
            pg8::gemm_phase<pg8::EpiRes, pg8::StaticOrder, true, true>(F.lds, g, S, E);
#endif
        } }
        SEAM(pb + 3);
        if (IN(pb + 4)) for (int rep = 0; rep < REP_NORM2; ++rep) { if (PHM(5)) norm_phase(args, F, l, 1); }
        SEAM(pb + 4);
        if (IN(pb + 5)) for (int rep = 0; rep < REP_FFN1; ++rep) { if (PHM(6)) {
#if REF_GEMM
            RefEpiSwiglu E{&args}; ref_gemm<64, RefEpiSwiglu>(F.lds, (const bf16*)(args.ws + WS_H), (const bf16*)(args.ws + WS_WF1) + (size_t)l * 2 * DFF * D, M, 2 * DFF, D, E);
#else
            pg8::Gemm g{(const bf16*)(args.ws + WS_H), (const bf16*)(args.ws + WS_WF1) + (size_t)l * 2 * DFF * D, M, 2 * DFF, D}; pg8::StaticOrder S; S.init(M, 2 * DFF, (int)gridDim.x, (int)blockIdx.x);
            pg8::EpiSwiglu E{(bf16*)(args.ws + WS_ACT)}; pg8::gemm_phase<pg8::EpiSwiglu, pg8::StaticOrder, true, true>(F.lds, g, S, E);
#endif
        } }
        SEAM(pb + 5);
        if (IN(pb + 6)) { if (PHM(7)) {
#if REF_GEMM
            RefEpiRes E{&args, &F, l, 5, 0}; ref_gemm<16, RefEpiRes>(F.lds, (const bf16*)(args.ws + WS_ACT), (const bf16*)(args.ws + WS_WF2) + (size_t)l * D * DFF, M, D, DFF, E);
#else
            pg8::Gemm g{(const bf16*)(args.ws + WS_ACT), (const bf16*)(args.ws + WS_WF2) + (size_t)l * D * DFF, M, D, DFF}; pg8::StaticOrder S; S.init(M, D, (int)gridDim.x, (int)blockIdx.x);
            pg8::EpiRes E{inp(F, 0), inp(F, 1), args.out, (const float*)(args.ws + WS_MOD) + (size_t)l * NCOND * NMOD + 5 * D, 0};
            pg8::gemm_phase<pg8::EpiRes, pg8::StaticOrder, true, true>(F.lds, g, S, E);
#endif
        } }
        SEAM(pb + 6);

#undef IN
#undef SEAM
}

__global__ void __launch_bounds__(NTHREADS, 2) mk_fwd(Args args) {
    extern __shared__ __attribute__((aligned(16))) unsigned char lds_raw[];
    Frame F;
    F.lds = (LAS unsigned char*)lds_raw;
    F.tid = threadIdx.x; F.lane = F.tid & 63; F.wave = __builtin_amdgcn_readfirstlane(F.tid >> 6);
    const int lo = args.ph_lo, hi = args.ph_hi;
    for (int u = F.tid; u < 256; u += NTHREADS) ((LAS unsigned*)(F.lds + LDSCTL_OFF))[u] = 0u;
    __syncthreads();
    if (F.tid < 25) ((LAS unsigned long long*)(F.lds + LDSCTL_OFF + 64))[F.tid] = (unsigned long long)args.in[F.tid];
    __syncthreads();
    XcdBarrier bar; bar.bar = (unsigned*)(args.ws + WS_CTL) + CW_BAR; bar.x = 0; bar.st = (volatile LAS unsigned*)(F.lds + LDSCTL_OFF) + 8;
    if (N_LAUNCHES == 1) bar = xcd_barrier_post((unsigned*)(args.ws + WS_CTL) + CW_BAR, (volatile LAS unsigned*)(F.lds + LDSCTL_OFF) + 8);
#define IN(k) (lo <= (k) && (k) < hi)
#define SEAM(k) do { if (N_LAUNCHES == 1 && IN(k) && IN((k) + 1)) xcd_barrier(bar); } while (0)
    if (IN(0)) for (int rep = 0; rep < REP_P0; ++rep) { if (PHM(0)) { p0_ada(args, F); p0_weights(args, F); p0_misc(args, F); } }
    SEAM(0);
    layer_phases<0>(args, F, bar, lo, hi);
    layer_phases<1>(args, F, bar, lo, hi);
    if (IN(15)) { if (PHM(8)) final_phase(args, F); }
#undef IN
#undef SEAM
}

extern "C" void kernel_launch(void* const* d_in, const int* in_sizes, int n_in, void* d_out, int out_size, void* d_ws, size_t ws_size, hipStream_t stream) {
    static int grid = 0;
    if (grid == 0) {
        if (n_in != 25 || ws_size < WS_END) { fprintf(stderr, "kernel_launch: expected 25 inputs and >= %zu bytes of workspace; got %d, %zu\n", (size_t)WS_END, n_in, ws_size); grid = -1; return; }
        int dev = 0, cus = 0;
        if (hipGetDevice(&dev) != hipSuccess || hipDeviceGetAttribute(&cus, hipDeviceAttributeMultiprocessorCount, dev) != hipSuccess) { grid = -1; return; }
        if (hipFuncSetAttribute((const void*)mk_fwd, hipFuncAttributeMaxDynamicSharedMemorySize, LDS_BYTES) != hipSuccess) { fprintf(stderr, "kernel_launch: hipFuncSetAttribute failed\n"); grid = -1; return; }
        grid = cus;
    }
    if (grid < 0) return;
    Args a{};
    for (int i = 0; i < 25; ++i) a.in[i] = (const float*)d_in[i];
    a.out = (float*)d_out; a.ws = (unsigned char*)d_ws;
    if (hipMemsetAsync((char*)d_ws + WS_CTL, 0, CTL_ZERO_BYTES, stream) != hipSuccess) { fprintf(stderr, "kernel_launch: hipMemsetAsync failed\n"); return; }
    if (N_LAUNCHES == 1) {
        a.ph_lo = 0; a.ph_hi = NPHASES;
        hipLaunchKernelGGL(mk_fwd, dim3(grid), dim3(NTHREADS), LDS_BYTES, stream, a);
    } else {
        for (int ph = 0; ph < NPHASES; ++ph) {
            a.ph_lo = ph; a.ph_hi = ph + 1;
            hipLaunchKernelGGL(mk_fwd, dim3(grid), dim3(NTHREADS), LDS_BYTES, stream, a);
        }
    }
}
```

```cpp
#include <hip/hip_runtime.h>
#include <cstdio>
#include <cstdint>

#ifndef REP_ATTN_BIG
#define REP_ATTN_BIG 1
#endif
#ifndef REP_P0
#define REP_P0 1
#endif
#ifndef REP_NORM1
#define REP_NORM1 1
#endif
#ifndef REP_INPROJ
#define REP_INPROJ 1
#endif
#ifndef REP_MIX
#define REP_MIX 1
#endif
#ifndef REP_NORM2
#define REP_NORM2 1
#endif
#ifndef REP_FFN1
#define REP_FFN1 1
#endif
#define LAS __attribute__((address_space(3)))
typedef unsigned short bf16;
typedef float f32x4 __attribute__((ext_vector_type(4)));
typedef unsigned u32x4 __attribute__((ext_vector_type(4)));
typedef unsigned u32x2 __attribute__((ext_vector_type(2)));

constexpr int D = 1024, MP = 4096, MS = 8192, M = MP + MS;
constexpr int LP = 256, LS = 1024, PAST = 256, LKS = PAST + LS;
constexpr int NIN = 2304, DFF = 2816, NMOD = 6 * D, NCOND = 9;
constexpr int NTHREADS = 512, NWAVES = 8;
constexpr float EPS = 1e-6f;
constexpr float QSCALE = 0.125f * 1.4426950408889634f;
constexpr int C_POOL = 0, C_Q = 256, C_K = 768, C_V = 1280, C_U = 1792, C_VG = 2048;
constexpr size_t OUT_YP = 0, OUT_YS = (size_t)MP * D, OUT_K = (size_t)M * D, OUT_V = OUT_K + (size_t)16 * 2 * 256 * 512;

constexpr size_t MiB = 1u << 20;
constexpr size_t WS_CTL = 0;
constexpr size_t WS_MOD = 1 * MiB;
constexpr size_t WS_ROPE = WS_MOD + 512 * 1024;
constexpr size_t WS_LAM = WS_ROPE + 16 * 1024;
constexpr size_t WS_WIN = 2 * MiB;
constexpr size_t WS_WOUT = WS_WIN + (size_t)2 * NIN * D * 2;
constexpr size_t WS_WF1 = WS_WOUT + (size_t)2 * D * D * 2;
constexpr size_t WS_WF2 = WS_WF1 + (size_t)2 * 2 * DFF * D * 2;
constexpr size_t WS_H = WS_WF2 + (size_t)2 * D * DFF * 2;
constexpr size_t WS_Q = WS_H + (size_t)M * D * 2;
constexpr size_t WS_KP = WS_Q + (size_t)M * 512 * 2;
constexpr size_t WS_KS = WS_KP + (size_t)16 * 256 * 512 * 2;
constexpr size_t WS_VTP = WS_KS + (size_t)8 * LKS * 512 * 2;
constexpr size_t WS_VTS = WS_VTP + (size_t)16 * 4 * 128 * 256 * 2;
constexpr size_t WS_PP = WS_VTS + (size_t)8 * 4 * 128 * LKS * 2;
constexpr size_t WS_U = WS_PP + (size_t)M * 256 * 2;
constexpr size_t WS_VG = WS_U + (size_t)M * 256 * 2;
constexpr size_t WS_MIX = WS_VG + (size_t)M * 256 * 2;
constexpr size_t WS_ACT = WS_MIX + (size_t)M * D * 2;
constexpr size_t WS_END = WS_ACT + (size_t)M * DFF * 2;
static_assert(WS_END <= 256 * MiB, "d_ws map exceeds 256 MiB");

constexpr int PHASE_LDS = 147456;
constexpr int LDSCTL_OFF = PHASE_LDS;
constexpr int LDS_BYTES = PHASE_LDS + 1024;
constexpr int CW_BAR = 4096;
constexpr size_t CTL_ZERO_BYTES = 65536;
#ifndef N_LAUNCHES
#define N_LAUNCHES 1
#endif

__device__ __forceinline__ unsigned f2bf(float f) { unsigned u = __builtin_bit_cast(unsigned, f); return (u + 0x7fffu + ((u >> 16) & 1u)) >> 16; }
__device__ __forceinline__ unsigned pk2(float lo, float hi) { return f2bf(lo) | (f2bf(hi) << 16); }
__device__ __forceinline__ float bf2f(unsigned b) { return __builtin_bit_cast(float, b << 16); }
__device__ __forceinline__ float bflo(unsigned w) { return __builtin_bit_cast(float, w << 16); }
__device__ __forceinline__ float bfhi(unsigned w) { return __builtin_bit_cast(float, w & 0xffff0000u); }
__device__ __forceinline__ float wave_sum(float v) {
#pragma unroll
    for (int o = 1; o < 64; o <<= 1) v += __shfl_xor(v, o);
    return v;
}
__device__ __forceinline__ float wave_max(float v) {
#pragma unroll
    for (int o = 1; o < 64; o <<= 1) v = fmaxf(v, __shfl_xor(v, o));
    return v;
}
__device__ __forceinline__ int perm16(int t) { return (t & ~12) | ((t & 4) << 1) | ((t & 8) >> 1); }
__device__ __forceinline__ float gelu_tanh(float x) {
    const float u = 0.7978845608028654f * (x + 0.044715f * x * x * x);
    const float e = __expf(2.0f * u);
    const float t = 1.0f - 2.0f / (e + 1.0f);
    return 0.5f * x * (1.0f + t);
}
__device__ __forceinline__ float silu_f(float x) { return x / (1.0f + __expf(-x)); }
__device__ __forceinline__ int cond_of_row(int m) { return m < MP ? 8 : ((m - MP) >> 10); }

struct Args {
    const float* in[25];
    float* out;
    unsigned char* ws;
    int ph_lo, ph_hi;
};

struct Frame {
    LAS unsigned char* lds;
    int tid, lane, wave;
};
__device__ __forceinline__ const float* inp(const Frame& F, int i) {
    const LAS unsigned* t = (const LAS unsigned*)(F.lds + PHASE_LDS + 64) + 2 * i;
    const unsigned lo = __builtin_amdgcn_readfirstlane(t[0]), hi = __builtin_amdgcn_readfirstlane(t[1]);
    typedef __attribute__((address_space(1))) const float gcf;
    return (const float*)(gcf*)(((unsigned long long)hi << 32) | (unsigned long long)lo);
}

__device__ __forceinline__ void p0_ada(const Args& a, Frame& F) {
    LAS float* sc = (LAS float*)F.lds;
    LAS float* red = sc + NCOND * D;
    const float* c = inp(F, 4); const float* cctx = inp(F, 5);
    const float* w_ada = inp(F, 7); const float* b_ada = inp(F, 8);
    float* mod = (float*)(a.ws + WS_MOD);
    bool have = false;
    for (int item = blockIdx.x; item < 2 * 96; item += gridDim.x) {
        if (!have) {
            for (int i = F.tid; i < NCOND * D; i += NTHREADS) { const int b = i >> 10, k = i & 1023; const float v = (b < 8) ? c[b * D + k] : cctx[k]; sc[i] = silu_f(v); }
            have = true;
        }
        __syncthreads();
        const int l = item / 96, n = (item % 96) * 64 + F.lane;
        const float* wp = w_ada + (size_t)l * D * NMOD + n;
        float acc[NCOND];
#pragma unroll
        for (int b = 0; b < NCOND; ++b) acc[b] = 0.f;
        const int k0 = F.wave * 128;
#pragma unroll 4
        for (int kk = 0; kk < 128; kk += 4) {
            const int k = k0 + kk;
            const float w0 = wp[(size_t)(k + 0) * NMOD], w1 = wp[(size_t)(k + 1) * NMOD], w2 = wp[(size_t)(k + 2) * NMOD], w3 = wp[(size_t)(k + 3) * NMOD];
#pragma unroll
            for (int b = 0; b < NCOND; ++b) { const f32x4 s = *(const LAS f32x4*)(sc + b * D + k); acc[b] += s.x * w0 + s.y * w1 + s.z * w2 + s.w * w3; }
        }
#pragma unroll
        for (int b = 0; b < NCOND; ++b) red[(F.wave * NCOND + b) * 64 + F.lane] = acc[b];
        __syncthreads();
        for (int i = F.tid; i < NCOND * 64; i += NTHREADS) {
            const int b = i >> 6, ln = i & 63; float s = 0.f;
#pragma unroll
            for (int w = 0; w < 8; ++w) s += red[(w * NCOND + b) * 64 + ln];
            const int nn = (item % 96) * 64 + ln;
            mod[((size_t)l * NCOND + b) * NMOD + nn] = s + b_ada[(size_t)l * NMOD + nn];
        }
        __syncthreads();
    }
    __syncthreads();
}
__device__ __forceinline__ void p0_transpose_item(const float* W, int K, int N, bf16* WT, int swz_ffn, LAS float* scr, int item, int lane) {
    const int nblk = N / 32, kb = item / nblk, nb = item % nblk, k0 = 64 * kb, n0 = 32 * nb;
#pragma unroll 8
    for (int i = 0; i < 32; ++i) { const int kk = 2 * i + (lane >> 5); scr[kk * 33 + (lane & 31)] = W[(size_t)(k0 + kk) * N + n0 + (lane & 31)]; }
    asm volatile("s_waitcnt lgkmcnt(0)" ::: "memory");
    int r0 = n0;
    if (swz_ffn) { r0 = (n0 < DFF) ? ((n0 >> 7) * 256 + (n0 & 127)) : (((n0 - DFF) >> 7) * 256 + 128 + ((n0 - DFF) & 127)); }
    const int c = lane & 7;
#pragma unroll
    for (int j = 0; j < 4; ++j) { const int n = (lane >> 3) + 8 * j; const LAS float* s = scr + (8 * c) * 33 + n;
        u32x4 o; o.x = pk2(s[0 * 33], s[1 * 33]); o.y = pk2(s[2 * 33], s[3 * 33]); o.z = pk2(s[4 * 33], s[5 * 33]); o.w = pk2(s[6 * 33], s[7 * 33]);
        *(u32x4*)(WT + (size_t)(r0 + n) * K + k0 + 8 * c) = o; }
    asm volatile("s_waitcnt lgkmcnt(0)" ::: "memory");
}
__device__ __forceinline__ void p0_weights(const Args& a, Frame& F) {
    LAS float* scr = (LAS float*)(F.lds) + F.wave * (64 * 33);
    const int gw = blockIdx.x * NWAVES + F.wave, NGW = gridDim.x * NWAVES;
    constexpr int I_IN = (D / 64) * (NIN / 32), I_OUT = (D / 64) * (D / 32), I_F1 = (D / 64) * (2 * DFF / 32), I_F2 = (DFF / 64) * (D / 32);
    constexpr int PER_L = I_IN + I_OUT + I_F1 + I_F2;
    for (int it = gw; it < 2 * PER_L; it += NGW) {
        const int l = it / PER_L; int r = it % PER_L;
        if (r < I_IN) { p0_transpose_item(inp(F, 9) + (size_t)l * D * NIN, D, NIN, (bf16*)(a.ws + WS_WIN) + (size_t)l * NIN * D, 0, scr, r, F.lane); continue; } r -= I_IN;
        if (r < I_OUT) { p0_transpose_item(inp(F, 20) + (size_t)l * D * D, D, D, (bf16*)(a.ws + WS_WOUT) + (size_t)l * D * D, 0, scr, r, F.lane); continue; } r -= I_OUT;
        if (r < I_F1) { p0_transpose_item(inp(F, 22) + (size_t)l * D * 2 * DFF, D, 2 * DFF, (bf16*)(a.ws + WS_WF1) + (size_t)l * 2 * DFF * D, 1, scr, r, F.lane); continue; } r -= I_F1;
        p0_transpose_item(inp(F, 23) + (size_t)l * DFF * D, DFF, D, (bf16*)(a.ws + WS_WF2) + (size_t)l * D * DFF, 0, scr, r, F.lane);
    }
}
__device__ __forceinline__ void p0_misc(const Args& a, Frame& F) {
    if (blockIdx.x == gridDim.x - 1) {
        float* rope = (float*)(a.ws + WS_ROPE);
        for (int i = F.tid; i < 64 * 16; i += NTHREADS) {
            const int pos = i >> 4, fi = i & 15;
            const float inv = (float)(1.0 / pow(10000.0, (double)fi / 16.0));
            const float ang = (float)pos * inv;
            rope[i] = (float)cos((double)ang); rope[1024 + i] = (float)sin((double)ang);
        }
        if (F.wave == 0) {
            float* lam = (float*)(a.ws + WS_LAM);
#pragma unroll
            for (int l = 0; l < 2; ++l) {
                const float d1 = wave_sum(inp(F, 12)[l * 64 + F.lane] * inp(F, 13)[l * 64 + F.lane]);
                const float d2 = wave_sum(inp(F, 14)[l * 64 + F.lane] * inp(F, 15)[l * 64 + F.lane]);
                const float lam_init = (l == 0) ? 0.2f : (float)(0.8 - 0.6 * 0.7408182206817179);
                if (F.lane == 0) lam[l] = expf(d1) - expf(d2) + lam_init;
            }
        }
    }
}

__device__ __forceinline__ const float* xrow_ptr(const Args& a, const Frame& F, int l_first, int m) {
    if (l_first) return (m < MP) ? inp(F, 0) + (size_t)m * D : inp(F, 1) + (size_t)(m - MP) * D;
    return a.out + (size_t)m * D;
}
__device__ __forceinline__ void norm_phase(const Args& a, Frame& F, int l, int which  ) {
    const float* g = (which == 0 ? inp(F, 6) : inp(F, 21)) + (size_t)l * D;
    const float* mod = (const float*)(a.ws + WS_MOD) + (size_t)l * NCOND * NMOD;
    const int sh_off = which == 0 ? 0 : 3 * D, sc_off = which == 0 ? D : 4 * D;
    bf16* H = (bf16*)(a.ws + WS_H);
    const int gw = blockIdx.x * NWAVES + F.wave, NGW = gridDim.x * NWAVES;
    for (int m = gw; m < M; m += NGW) {
        const f32x4* xr = (const f32x4*)xrow_ptr(a, F, (l == 0 && which == 0), m) + F.lane;
        f32x4 v[4]; float s = 0.f;
#pragma unroll
        for (int j = 0; j < 4; ++j) { v[j] = xr[64 * j]; s += (v[j].x * v[j].x + v[j].y * v[j].y) + (v[j].z * v[j].z + v[j].w * v[j].w); }
        const float rstd = 1.0f / sqrtf(wave_sum(s) * (1.0f / D) + EPS);
        const float* mb = mod + (size_t)cond_of_row(m) * NMOD;
        unsigned long long* o8 = (unsigned long long*)(H + (size_t)m * D) + F.lane;
#pragma unroll
        for (int j = 0; j < 4; ++j) {
            const int col = 4 * (64 * j + F.lane);
            const f32x4 gv = *(const f32x4*)(g + col), scv = *(const f32x4*)(mb + sc_off + col), shv = *(const f32x4*)(mb + sh_off + col);
            const float y0 = v[j].x * rstd * gv.x * (1.0f + scv.x) + shv.x, y1 = v[j].y * rstd * gv.y * (1.0f + scv.y) + shv.y;
            const float y2 = v[j].z * rstd * gv.z * (1.0f + scv.z) + shv.z, y3 = v[j].w * rstd * gv.w * (1.0f + scv.w) + shv.w;
            o8[64 * j] = (unsigned long long)pk2(y0, y1) | ((unsigned long long)pk2(y2, y3) << 32);
        }
    }
}
__device__ __forceinline__ void cache_phase(const Args& a, Frame& F, int l) {
    const float* ck = inp(F, 2); const float* cv = inp(F, 3);
    bf16* KS = (bf16*)(a.ws + WS_KS); bf16* VTS = (bf16*)(a.ws + WS_VTS);
    const int gt = blockIdx.x * NTHREADS + F.tid, NT = gridDim.x * NTHREADS;
    for (int i = gt; i < 8 * 256 * 128; i += NT) {
        const int b = i / (256 * 128), r = i % (256 * 128), pos = r / 128, c4 = (r % 128) * 4;
        const f32x4 v = *(const f32x4*)(ck + (((size_t)(b * 2 + l) * 256 + pos) * 512 + c4));
        *(u32x2*)(KS + ((size_t)(b * LKS + pos) * 512 + c4)) = (u32x2){pk2(v.x, v.y), pk2(v.z, v.w)};
    }
    LAS float* T = (LAS float*)F.lds;
    for (int item = blockIdx.x; item < 8 * 4 * 4; item += gridDim.x) {
        const int b = item >> 4, h = (item >> 2) & 3, pblk = item & 3;
        __syncthreads();
        { const int pos = F.tid >> 3, c16 = (F.tid & 7) * 16;
          const float* src = cv + (((size_t)(b * 2 + l) * 256 + pblk * 64 + pos) * 512 + h * 128 + c16);
#pragma unroll
          for (int k = 0; k < 4; ++k) { const f32x4 v = *(const f32x4*)(src + 4 * k); LAS float* d = T + pos * 129 + c16 + 4 * k; d[0] = v.x; d[1] = v.y; d[2] = v.z; d[3] = v.w; } }
        __syncthreads();
        { const int d = F.tid >> 2, ch = F.tid & 3;
          unsigned w[8];
#pragma unroll
          for (int k = 0; k < 8; ++k) { const int p0 = 16 * ch + perm16(2 * k), p1 = 16 * ch + perm16(2 * k + 1); w[k] = pk2(T[p0 * 129 + d], T[p1 * 129 + d]); }
          bf16* dst = VTS + ((size_t)(b * 4 + h) * 128 + d) * LKS + pblk * 64 + 16 * ch;
          *(u32x4*)dst = (u32x4){w[0], w[1], w[2], w[3]}; *(u32x4*)(dst + 8) = (u32x4){w[4], w[5], w[6], w[7]}; }
    }
    __syncthreads();
}

template <int TX, class Epi>
__device__ __forceinline__ void ref_gemm(LAS unsigned char* lds, const bf16* A, const bf16* Bt, int Mr, int N, int K, const Epi& epi) {
    constexpr int TY = NTHREADS / TX, BMn = 4 * TY, BNn = 4 * TX;
    LAS float* As = (LAS float*)lds;
    LAS float* Bs = As + BMn * 33;
    const int tid = threadIdx.x, tx = tid % TX, ty = tid / TX;
    const int ntn = N / BNn, ntm = Mr / BMn;
    for (int tile = blockIdx.x; tile < ntm * ntn; tile += gridDim.x) {
        const int tm = tile / ntn, tn = tile % ntn;
        float acc[4][4];
#pragma unroll
        for (int i = 0; i < 4; ++i)
#pragma unroll
            for (int j = 0; j < 4; ++j) acc[i][j] = 0.f;
        for (int k0 = 0; k0 < K; k0 += 32) {
            __syncthreads();
            for (int ch = tid; ch < BMn * 4; ch += NTHREADS) { const int r = ch >> 2, c8 = (ch & 3) * 8;
                const u32x4 v = *(const u32x4*)(A + (size_t)(tm * BMn + r) * K + k0 + c8); LAS float* d = As + r * 33 + c8;
                d[0] = bflo(v.x); d[1] = bfhi(v.x); d[2] = bflo(v.y); d[3] = bfhi(v.y); d[4] = bflo(v.z); d[5] = bfhi(v.z); d[6] = bflo(v.w); d[7] = bfhi(v.w); }
            for (int ch = tid; ch < BNn * 4; ch += NTHREADS) { const int r = ch >> 2, c8 = (ch & 3) * 8;
                const u32x4 v = *(const u32x4*)(Bt + (size_t)(tn * BNn + r) * K + k0 + c8); LAS float* d = Bs + r * 33 + c8;
                d[0] = bflo(v.x); d[1] = bfhi(v.x); d[2] = bflo(v.y); d[3] = bfhi(v.y); d[4] = bflo(v.z); d[5] = bfhi(v.z); d[6] = bflo(v.w); d[7] = bfhi(v.w); }
            __syncthreads();
#pragma unroll 8
            for (int kk = 0; kk < 32; ++kk) {
                float av[4], bv[4];
#pragma unroll
                for (int i = 0; i < 4; ++i) av[i] = As[(ty + TY * i) * 33 + kk];
#pragma unroll
                for (int j = 0; j < 4; ++j) bv[j] = Bs[(tx + TX * j) * 33 + kk];
#pragma unroll
                for (int i = 0; i < 4; ++i)
#pragma unroll
                    for (int j = 0; j < 4; ++j) acc[i][j] += av[i] * bv[j];
            }
        }
#pragma unroll
        for (int i = 0; i < 4; ++i) epi(tm * BMn + ty + TY * i, tn * BNn, tx, acc[i]);
    }
    __syncthreads();
}

struct RefEpiIn {
    const Args* a; int l;
    __device__ __forceinline__ void operator()(int m, int cb, int tx, const float (&v)[4]) const {
        unsigned char* ws = a->ws;
        const bool smp = m >= MP;
        const int b = smp ? ((m - MP) >> 10) : (m >> 8), t = smp ? ((m - MP) & 1023) : (m & 255);
        if (cb < C_Q) {
            bf16* P = (bf16*)(ws + WS_PP) + (size_t)m * 256 + cb + tx;
#pragma unroll
            for (int j = 0; j < 4; ++j) P[16 * j] = (bf16)f2bf(v[j]);
        } else if (cb < C_V) {
            float o[4] = {v[0], v[1], v[2], v[3]};
            if (smp) {
                const float* rope = (const float*)(ws + WS_ROPE);
                const int pr = t >> 6, pc = t & 63;
                const float cr = rope[pr * 16 + tx], sr = rope[1024 + pr * 16 + tx], cc = rope[pc * 16 + tx], sn = rope[1024 + pc * 16 + tx];
                o[0] = v[0] * cr - v[1] * sr; o[1] = v[1] * cr + v[0] * sr;
                o[2] = v[2] * cc - v[3] * sn; o[3] = v[3] * cc + v[2] * sn;
            }
            if (cb < C_K) {
                bf16* Q = (bf16*)(ws + WS_Q) + (size_t)m * 512 + (cb - C_Q) + tx;
#pragma unroll
                for (int j = 0; j < 4; ++j) Q[16 * j] = (bf16)f2bf(o[j] * QSCALE);
            } else {
                const int col = (cb - C_K) + tx;
                bf16* Kd = smp ? (bf16*)(ws + WS_KS) + ((size_t)(b * LKS + PAST + t) * 512 + col) : (bf16*)(ws + WS_KP) + ((size_t)(b * LP + t) * 512 + col);
#pragma unroll
                for (int j = 0; j < 4; ++j) Kd[16 * j] = (bf16)f2bf(o[j]);
                if (!smp) { float* ok = a->out + OUT_K + ((size_t)(b * 2 + l) * 256 + t) * 512 + col;
#pragma unroll
                    for (int j = 0; j < 4; ++j) ok[16 * j] = o[j]; }
            }
        } else if (cb < C_U) {
#pragma unroll
            for (int j = 0; j < 4; ++j) {
                const int col = (cb - C_V) + tx + 16 * j, h = col >> 7, d = col & 127;
                if (smp) ((bf16*)(ws + WS_VTS))[((size_t)(b * 4 + h) * 128 + d) * LKS + PAST + perm16(t)] = (bf16)f2bf(v[j]);
                else { ((bf16*)(ws + WS_VTP))[((size_t)(b * 4 + h) * 128 + d) * LP + perm16(t)] = (bf16)f2bf(v[j]);
                       a->out[OUT_V + ((size_t)(b * 2 + l) * 256 + t) * 512 + col] = v[j]; }
            }
        } else {
            bf16* U = (cb < C_VG) ? (bf16*)(ws + WS_U) + (size_t)m * 256 + (cb - C_U) + tx : (bf16*)(ws + WS_VG) + (size_t)m * 256 + (cb - C_VG) + tx;
#pragma unroll
            for (int j = 0; j < 4; ++j) U[16 * j] = (bf16)f2bf(gelu_tanh(v[j]));
        }
    }
};
struct RefEpiRes {
    const Args* a; const Frame* Fp; int l; int gi; int first;
    __device__ __forceinline__ void operator()(int m, int cb, int tx, const float (&v)[4]) const {
        const float* src = xrow_ptr(*a, *Fp, first, m);
        const float* gate = (const float*)(a->ws + WS_MOD) + ((size_t)l * NCOND + cond_of_row(m)) * NMOD + gi * D;
        float* X = a->out + (size_t)m * D;
#pragma unroll
        for (int j = 0; j < 4; ++j) { const int n = cb + tx + 16 * j; X[n] = src[n] + gate[n] * v[j]; }
    }
};
struct RefEpiSwiglu {
    const Args* a;
    __device__ __forceinline__ void operator()(int m, int cb, int tx, const float (&v)[4]) const {
        bf16* ACT = (bf16*)(a->ws + WS_ACT) + (size_t)m * DFF + (cb >> 1) + tx;
        ACT[0] = (bf16)f2bf(silu_f(v[0]) * v[2]);
        ACT[64] = (bf16)f2bf(silu_f(v[1]) * v[3]);
    }
};

namespace pg8 {
#define PG8_LAS __attribute__((address_space(3)))
typedef unsigned short bf16_t;
typedef short bf16x8 __attribute__((ext_vector_type(8)));
typedef float f32x4 __attribute__((ext_vector_type(4)));
typedef unsigned u32x4 __attribute__((ext_vector_type(4)));
constexpr int BM = 256, BK = 64, HALF = 128, HTB = HALF * BK * 2  , STAGE_BYTES = 8 * HTB, NXCD = 8, WGM = 8;

__host__ __device__ __forceinline__ int lds_byte(int r, int c) { const int st = (r >> 4) * 2 + (c >> 5), rr = r & 15, cc = c & 31, ob = rr * 64 + cc * 2; return st * 1024 + (ob ^ (((ob >> 9) & 1) << 5)); }
__host__ __device__ __forceinline__ void stage_rc(int b, int& R, int& C) { const int st = b / 1024, sb = b % 1024, swz = sb ^ (((sb >> 9) & 1) << 5); R = (st >> 1) * 16 + swz / 64; C = (st & 1) * 32 + (swz % 64) / 2; }
__host__ __device__ __forceinline__ int perm32(int rho) { const int n = rho >> 4, i = rho & 15; return 8 * (i >> 2) + 4 * n + (i & 3); }

struct Unit { int pm, pn; };
struct Gemm { const bf16_t* A; const bf16_t* Bt; int M, N, K; };

struct StaticOrder {
    int nM, nN, nwg, G, c;
    __host__ __device__ void init(int M, int N, int G_, int c_) { nM = M / BM; nN = N / BM; nwg = nM * nN; G = G_; c = c_; }
    __host__ __device__ bool next(int i, Unit& u) const {
        const long L = (long)i * G + c; if (L >= nwg) return false;
        int wgid = (int)L; { const int q = nwg / NXCD, r = nwg % NXCD, xcd = wgid % NXCD, off = wgid / NXCD; wgid = (xcd < r ? xcd * (q + 1) : r * (q + 1) + (xcd - r) * q) + off; }
        const int nig = WGM * nN, gid = wgid / nig, fm = gid * WGM, gsz = (nM - fm) < WGM ? (nM - fm) : WGM;
        u.pm = fm + ((wgid % nig) % gsz); u.pn = (wgid % nig) / gsz; return true;
    }
    __device__ __forceinline__ void a_ready(const Unit&) const {}
    __device__ __forceinline__ void done(const Unit&) const {}
};
__device__ __forceinline__ unsigned cvt_pk_bf16(float lo, float hi) { unsigned r; asm volatile("v_cvt_pk_bf16_f32 %0, %1, %2" : "=v"(r) : "v"(lo), "v"(hi)); return r; }

__device__ __forceinline__ float fast_silu(float x) { return x * __builtin_amdgcn_rcpf(1.0f + __expf(-x)); }
__device__ __forceinline__ float fast_gelu_tanh(float x) {
    const float u = 0.7978845608028654f * (x + 0.044715f * x * x * x);
    const float t = 1.0f - 2.0f * __builtin_amdgcn_rcpf(__expf(2.0f * u) + 1.0f);
    return 0.5f * x * (1.0f + t);
}
typedef unsigned u32x2v __attribute__((ext_vector_type(2)));
struct EpiIn {
    static constexpr bool PERM = false, AFTER_DRAIN = false;
    unsigned char* ws; float* out; int l;
    __device__ __forceinline__ void operator()(const f32x4 (&acc)[2][2][4][2], const Unit& u, int wr, int wc, int fr, int fq) const {
        const bool smp = u.pm >= 16;
        const int b = smp ? ((u.pm - 16) >> 2) : u.pm;
        const int tb = (smp ? ((u.pm - 16) & 3) * 256 : 0) + wr * 64 + fr;
        const int rowb = u.pm * BM + wr * 64 + fr;
        const int pn = u.pn;
        if (pn == 0) {
            bf16_t* P = (bf16_t*)(ws + WS_PP) + (size_t)rowb * 256 + wc * 32 + 4 * fq;
#pragma unroll
            for (int ai = 0; ai < 2; ++ai)
#pragma unroll
                for (int m = 0; m < 4; ++m)
#pragma unroll
                    for (int bj = 0; bj < 2; ++bj)
#pragma unroll
                        for (int n = 0; n < 2; ++n) { const f32x4 v = acc[ai][bj][m][n];
                            *(u32x2v*)(P + (size_t)(ai * HALF + m * 16) * 256 + bj * HALF + n * 16) = (u32x2v){cvt_pk_bf16(v[0], v[1]), cvt_pk_bf16(v[2], v[3])}; }
        } else if (pn <= 4) {
            const bool isq = pn <= 2;
            const int colt = (isq ? (pn - 1) : (pn - 3)) * 256 + wc * 32 + 4 * fq;
            const float* rope = (const float*)(ws + WS_ROPE);
#pragma unroll
            for (int ai = 0; ai < 2; ++ai)
#pragma unroll
                for (int m = 0; m < 4; ++m) {
                    const int t = tb + ai * HALF + m * 16, row = rowb + ai * HALF + m * 16;
                    f32x4 cs = {1.f, 1.f, 1.f, 1.f}, sn = {0.f, 0.f, 0.f, 0.f};
                    if (smp) { const int pos = (wc & 1) ? (t & 63) : (t >> 6); cs = *(const f32x4*)(rope + pos * 16 + 4 * fq); sn = *(const f32x4*)(rope + 1024 + pos * 16 + 4 * fq); }
#pragma unroll
                    for (int bj = 0; bj < 2; ++bj) {
                        const f32x4 x1 = acc[ai][bj][m][0], x2 = acc[ai][bj][m][1];
                        f32x4 o1 = x1 * cs - x2 * sn, o2 = x2 * cs + x1 * sn;
                        const int col = colt + bj * HALF;
                        if (isq) {
                            o1 = o1 * QSCALE; o2 = o2 * QSCALE;
                            bf16_t* q = (bf16_t*)(ws + WS_Q) + (size_t)row * 512 + col;
                            *(u32x2v*)(q) = (u32x2v){cvt_pk_bf16(o1[0], o1[1]), cvt_pk_bf16(o1[2], o1[3])};
                            *(u32x2v*)(q + 16) = (u32x2v){cvt_pk_bf16(o2[0], o2[1]), cvt_pk_bf16(o2[2], o2[3])};
                        } else {
                            bf16_t* k = smp ? (bf16_t*)(ws + WS_KS) + ((size_t)(b * LKS + PAST + t) * 512 + col) : (bf16_t*)(ws + WS_KP) + ((size_t)(b * LP + t) * 512 + col);
                            *(u32x2v*)(k) = (u32x2v){cvt_pk_bf16(o1[0], o1[1]), cvt_pk_bf16(o1[2], o1[3])};
                            *(u32x2v*)(k + 16) = (u32x2v){cvt_pk_bf16(o2[0], o2[1]), cvt_pk_bf16(o2[2], o2[3])};
                            if (!smp) { float* ok = out + OUT_K + ((size_t)(b * 2 + l) * 256 + t) * 512 + col; *(f32x4*)ok = o1; *(f32x4*)(ok + 16) = o2; }
                        }
                    }
                }
        } else if (pn <= 6) {
            const int Lk = smp ? LKS : LP, koff = smp ? PAST : 0;
            bf16_t* vt = smp ? (bf16_t*)(ws + WS_VTS) : (bf16_t*)(ws + WS_VTP);
#pragma unroll
            for (int ai = 0; ai < 2; ++ai)
#pragma unroll
                for (int m = 0; m < 4; ++m) {
                    const int t = tb + ai * HALF + m * 16;
                    const int pt = koff + ((t & ~12) | ((t & 4) << 1) | ((t & 8) >> 1));
#pragma unroll
                    for (int bj = 0; bj < 2; ++bj) {
                        const int h = 2 * (pn - 5) + bj;
#pragma unroll
                        for (int n = 0; n < 2; ++n) {
                            const f32x4 v = acc[ai][bj][m][n];
                            const int d0 = wc * 32 + n * 16 + 4 * fq;
                            bf16_t* dst = vt + ((size_t)(b * 4 + h) * 128 + d0) * Lk + pt;
                            const unsigned w01 = cvt_pk_bf16(v[0], v[1]), w23 = cvt_pk_bf16(v[2], v[3]);
                            dst[0] = (bf16_t)(w01 & 0xffffu); dst[(size_t)Lk] = (bf16_t)(w01 >> 16); dst[(size_t)2 * Lk] = (bf16_t)(w23 & 0xffffu); dst[(size_t)3 * Lk] = (bf16_t)(w23 >> 16);
                            if (!smp) *(f32x4*)(out + OUT_V + ((size_t)(b * 2 + l) * 256 + t) * 512 + (pn - 5) * 256 + bj * HALF + d0) = v;
                        }
                    }
                }
        } else {
            bf16_t* U = (bf16_t*)(ws + (pn == 7 ? WS_U : WS_VG)) + (size_t)rowb * 256 + wc * 32 + 4 * fq;
#pragma unroll
            for (int ai = 0; ai < 2; ++ai)
#pragma unroll
                for (int m = 0; m < 4; ++m)
#pragma unroll
                    for (int bj = 0; bj < 2; ++bj)
#pragma unroll
                        for (int n = 0; n < 2; ++n) { const f32x4 v = acc[ai][bj][m][n];
                            *(u32x2v*)(U + (size_t)(ai * HALF + m * 16) * 256 + bj * HALF + n * 16) =
                                (u32x2v){cvt_pk_bf16(fast_gelu_tanh(v[0]), fast_gelu_tanh(v[1])), cvt_pk_bf16(fast_gelu_tanh(v[2]), fast_gelu_tanh(v[3]))}; }
        }
    }
};
struct EpiRes {
    static constexpr bool PERM = false, AFTER_DRAIN = false;
    const float* xp; const float* xs; float* X; const float* gate_l; int first;
    __device__ __forceinline__ void operator()(const f32x4 (&acc)[2][2][4][2], const Unit& u, int wr, int wc, int fr, int fq) const {
        const bool smp = u.pm >= 16;
        const int cb = smp ? ((u.pm - 16) >> 2) : 8;
        const int col0 = u.pn * BM + wc * 32 + 4 * fq;
        const float* gate = gate_l + (size_t)cb * NMOD + col0;
        f32x4 gv[2][2];
#pragma unroll
        for (int bj = 0; bj < 2; ++bj)
#pragma unroll
            for (int n = 0; n < 2; ++n) gv[bj][n] = *(const f32x4*)(gate + bj * HALF + n * 16);
        const int row0 = u.pm * BM + wr * 64 + fr;
        const float* sbase = first ? (smp ? xs + (size_t)(row0 - MP) * D : xp + (size_t)row0 * D) : X + (size_t)row0 * D;
        float* obase = X + (size_t)row0 * D;
#pragma unroll
        for (int ai = 0; ai < 2; ++ai)
#pragma unroll
            for (int m = 0; m < 4; ++m) {
                const size_t ro = (size_t)(ai * HALF + m * 16) * D + col0;
#pragma unroll
                for (int bj = 0; bj < 2; ++bj)
#pragma unroll
                    for (int n = 0; n < 2; ++n) { const f32x4 sv = *(const f32x4*)(sbase + ro + bj * HALF + n * 16); *(f32x4*)(obase + ro + bj * HALF + n * 16) = sv + gv[bj][n] * acc[ai][bj][m][n]; }
                if (m & 1) asm volatile("" ::: "memory");
            }
    }
};
struct EpiSwiglu {
    static constexpr bool PERM = true, AFTER_DRAIN = false;
    bf16_t* ACT;
    __device__ __forceinline__ void operator()(const f32x4 (&acc)[2][2][4][2], const Unit& u, int wr, int wc, int fr, int fq) const {
        bf16_t* base = ACT + (size_t)(u.pm * BM + wr * 64 + fr) * DFF + u.pn * HALF + wc * 32 + 8 * fq;
#pragma unroll
        for (int ai = 0; ai < 2; ++ai)
#pragma unroll
            for (int m = 0; m < 4; ++m) {
                const f32x4 g0 = acc[ai][0][m][0], g1 = acc[ai][0][m][1], u0 = acc[ai][1][m][0], u1 = acc[ai][1][m][1];
                u32x4 w;
                w.x = cvt_pk_bf16(fast_silu(g0[0]) * u0[0], fast_silu(g0[1]) * u0[1]); w.y = cvt_pk_bf16(fast_silu(g0[2]) * u0[2], fast_silu(g0[3]) * u0[3]);
                w.z = cvt_pk_bf16(fast_silu(g1[0]) * u1[0], fast_silu(g1[1]) * u1[1]); w.w = cvt_pk_bf16(fast_silu(g1[2]) * u1[2], fast_silu(g1[3]) * u1[3]);
                *(u32x4*)(base + (size_t)(ai * HALF + m * 16) * DFF) = w;
            }
    }
};

template <class Epi, class Sched, bool ALIGN_EPI = false, bool SP2 = false>
__device__ __forceinline__ void gemm_phase(PG8_LAS unsigned char* lds, const Gemm g, const Sched& S, const Epi& E) {
    const int tid = threadIdx.x, wid = __builtin_amdgcn_readfirstlane(tid >> 6), lane = tid & 63, wr = wid >> 2, wc = wid & 3, fr = lane & 15, fq = lane >> 4;
    const int K = g.K, nt = K / BK;
    unsigned voffA[2], voffB[2];
#pragma unroll
    for (int i = 0; i < 2; ++i) { int R, C; stage_rc(tid * 16 + i * 8192, R, C); const int Rb = Epi::PERM ? ((R & ~31) + perm32(R & 31)) : R;
        voffA[i] = (unsigned)(R * K + C) * 2u; voffB[i] = (unsigned)(Rb * K + C) * 2u; }
    const size_t kstep = (size_t)(BK * 2);
    const size_t hstep = (size_t)HALF * K * 2;
    const size_t tstep = 2 * hstep;
    const unsigned ldsw = (unsigned)wid * 1024u;
    const int aoff = lds_byte(wr * 64 + fr, fq * 8), boff = lds_byte(wc * 32 + fr, fq * 8);
#define PG8_SA(b, h) (((b) * 2 + (h)) * HTB)
#define PG8_SB(b, h) ((4 + (b) * 2 + (h)) * HTB)
#define PG8_STAGE(bufoff, gbase, voff) do { _Pragma("unroll") for (int _i = 0; _i < 2; ++_i) \
        __builtin_amdgcn_global_load_lds((const unsigned*)((const char*)(gbase) + (voff)[_i]), (PG8_LAS unsigned*)(lds + (bufoff) + ldsw + _i * 8192), 16, 0, 0); } while (0)
#define PG8_LDA(dst, b, h) do { _Pragma("unroll") for (int m = 0; m < 4; ++m) _Pragma("unroll") for (int k = 0; k < 2; ++k) dst[m][k] = *(const PG8_LAS bf16x8*)(lds + PG8_SA(b, h) + aoff + m * 2048 + k * 1024); } while (0)
#define PG8_LDB(dst, b, h) do { _Pragma("unroll") for (int n = 0; n < 2; ++n) _Pragma("unroll") for (int k = 0; k < 2; ++k) dst[n][k] = *(const PG8_LAS bf16x8*)(lds + PG8_SB(b, h) + boff + n * 2048 + k * 1024); } while (0)
#define PG8_MMA(ai, bj, At, Bt) do { __builtin_amdgcn_s_setprio(1); _Pragma("unroll") for (int m = 0; m < 4; ++m) _Pragma("unroll") for (int n = 0; n < 2; ++n) _Pragma("unroll") for (int k = 0; k < 2; ++k) \
        acc[ai][bj][m][n] = __builtin_amdgcn_mfma_f32_16x16x32_bf16(Bt[n][k], At[m][k], acc[ai][bj][m][n], 0, 0, 0); __builtin_amdgcn_s_setprio(0); } while (0)
#define PG8_WAIT_V(n) asm volatile("s_waitcnt vmcnt(" #n ")" ::: "memory")
#define PG8_WAIT_L(n) asm volatile("s_waitcnt lgkmcnt(" #n ")" ::: "memory")
#define PG8_BAR __builtin_amdgcn_s_barrier()
#define PG8_SCHED __builtin_amdgcn_sched_barrier(0)
    Unit cur, nxt; int ui = 0;
    if (!S.next(0, cur)) return;
    f32x4 acc[2][2][4][2];
#pragma unroll
    for (int a = 0; a < 2; ++a)
#pragma unroll
        for (int b = 0; b < 2; ++b)
#pragma unroll
            for (int m = 0; m < 4; ++m)
#pragma unroll
                for (int n = 0; n < 2; ++n) acc[a][b][m][n] = (f32x4){0.f, 0.f, 0.f, 0.f};
    bf16x8 At[4][2], B0[2][2], B1[2][2];
    const char* cA = (const char*)g.A + (size_t)cur.pm * tstep; const char* cB = (const char*)g.Bt + (size_t)cur.pn * tstep;
    S.a_ready(cur);
    if constexpr (SP2) {
        PG8_STAGE(PG8_SB(0, 0), cB, voffB); PG8_STAGE(PG8_SB(0, 1), cB + hstep, voffB); PG8_STAGE(PG8_SA(0, 0), cA, voffA); PG8_STAGE(PG8_SA(0, 1), cA + hstep, voffA);
        if (wr == 1) PG8_BAR;
        PG8_WAIT_V(2); PG8_BAR;
        PG8_STAGE(PG8_SB(1, 0), cB + kstep, voffB); PG8_STAGE(PG8_SA(1, 0), cA + kstep, voffA); PG8_STAGE(PG8_SB(1, 1), cB + hstep + kstep, voffB);
        PG8_WAIT_V(6); PG8_BAR;
    } else {
        PG8_STAGE(PG8_SB(0, 0), cB, voffB); PG8_STAGE(PG8_SA(0, 0), cA, voffA); PG8_STAGE(PG8_SB(0, 1), cB + hstep, voffB); PG8_STAGE(PG8_SA(0, 1), cA + hstep, voffA);
        if (wr == 1) PG8_BAR;
        PG8_WAIT_V(4); PG8_BAR;
        PG8_STAGE(PG8_SB(1, 0), cB + kstep, voffB); PG8_STAGE(PG8_SA(1, 0), cA + kstep, voffA); PG8_STAGE(PG8_SB(1, 1), cB + hstep + kstep, voffB);
        PG8_WAIT_V(6); PG8_BAR;
    }
    for (;;) {
        const bool has_next = S.next(ui + 1, nxt);
        const char* nA = has_next ? (const char*)g.A + (size_t)nxt.pm * tstep : cA; const char* nB = has_next ? (const char*)g.Bt + (size_t)nxt.pn * tstep : cB;
        for (int t = 0; t < nt; t += 2) {
            const bool last = (t == nt - 2);
            const char* a1 = cA + (size_t)(t + 1) * kstep;
            const char* a2 = last ? nA : cA + (size_t)(t + 2) * kstep; const char* b2 = last ? nB : cB + (size_t)(t + 2) * kstep;
            const char* a3 = a2 + kstep; const char* b3 = b2 + kstep;
            if (last && has_next) S.a_ready(nxt);
            if constexpr (SP2) {
            PG8_LDB(B0, 0, 0); PG8_LDB(B1, 0, 1); PG8_SCHED; PG8_LDA(At, 0, 0); PG8_STAGE(PG8_SA(1, 1), a1 + hstep, voffA);
            PG8_WAIT_V(8); PG8_WAIT_L(0); PG8_BAR; PG8_MMA(0, 0, At, B0); PG8_MMA(0, 1, At, B1); PG8_BAR; PG8_SCHED;
            PG8_LDA(At, 0, 1); PG8_STAGE(PG8_SB(0, 0), b2, voffB); PG8_STAGE(PG8_SB(0, 1), b2 + hstep, voffB); PG8_STAGE(PG8_SA(0, 0), a2, voffA);
            PG8_WAIT_V(8); PG8_WAIT_L(0); PG8_BAR; PG8_MMA(1, 0, At, B0); PG8_MMA(1, 1, At, B1); PG8_BAR; PG8_SCHED;
            PG8_LDB(B0, 1, 0); PG8_LDB(B1, 1, 1); PG8_SCHED; PG8_LDA(At, 1, 0); PG8_STAGE(PG8_SA(0, 1), a2 + hstep, voffA);
            PG8_WAIT_V(8); PG8_WAIT_L(0); PG8_BAR; PG8_MMA(0, 0, At, B0); PG8_MMA(0, 1, At, B1); PG8_BAR; PG8_SCHED;
            PG8_LDA(At, 1, 1); PG8_STAGE(PG8_SB(1, 0), b3, voffB); PG8_STAGE(PG8_SB(1, 1), b3 + hstep, voffB); PG8_STAGE(PG8_SA(1, 0), a3, voffA);
            PG8_WAIT_V(8); PG8_WAIT_L(0); PG8_BAR; PG8_MMA(1, 0, At, B0); PG8_MMA(1, 1, At, B1); PG8_BAR; PG8_SCHED;
            } else {
            PG8_LDB(B0, 0, 0); PG8_SCHED; PG8_LDA(At, 0, 0); PG8_STAGE(PG8_SA(1, 1), a1 + hstep, voffA);
            PG8_WAIT_L(8); PG8_BAR; PG8_WAIT_L(0); PG8_MMA(0, 0, At, B0); PG8_BAR; PG8_SCHED;
            PG8_LDB(B1, 0, 1); PG8_STAGE(PG8_SB(0, 0), b2, voffB);
            PG8_BAR; PG8_WAIT_L(0); PG8_MMA(0, 1, At, B1); PG8_BAR;
            PG8_LDA(At, 0, 1); PG8_STAGE(PG8_SA(0, 0), a2, voffA);
            PG8_BAR; PG8_WAIT_L(0); PG8_MMA(1, 0, At, B0); PG8_BAR; PG8_SCHED;
            PG8_STAGE(PG8_SB(0, 1), b2 + hstep, voffB);
            PG8_WAIT_V(6); PG8_BAR; PG8_MMA(1, 1, At, B1); PG8_BAR;
            PG8_LDB(B0, 1, 0); PG8_SCHED; PG8_LDA(At, 1, 0); PG8_STAGE(PG8_SA(0, 1), a2 + hstep, voffA);
            PG8_WAIT_L(8); PG8_BAR; PG8_WAIT_L(0); PG8_MMA(0, 0, At, B0); PG8_BAR; PG8_SCHED;
            PG8_LDB(B1, 1, 1); PG8_STAGE(PG8_SB(1, 0), b3, voffB);
            PG8_BAR; PG8_WAIT_L(0); PG8_MMA(0, 1, At, B1); PG8_BAR;
            PG8_LDA(At, 1, 1); PG8_STAGE(PG8_SA(1, 0), a3, voffA);
            PG8_BAR; PG8_WAIT_L(0); PG8_MMA(1, 0, At, B0); PG8_BAR; PG8_SCHED;
            PG8_STAGE(PG8_SB(1, 1), b3 + hstep, voffB);
            PG8_WAIT_V(6); PG8_BAR; PG8_MMA(1, 1, At, B1); PG8_BAR;
            }
        }
        if constexpr (ALIGN_EPI) { if (wr == 0) PG8_BAR; }
        if constexpr (!Epi::AFTER_DRAIN) { E(acc, cur, wr, wc, fr, fq); S.done(cur); }
        if (!has_next) break;
#pragma unroll
        for (int a = 0; a < 2; ++a)
#pragma unroll
            for (int b = 0; b < 2; ++b)
#pragma unroll
                for (int m = 0; m < 4; ++m)
#pragma unroll
                    for (int n = 0; n < 2; ++n) acc[a][b][m][n] = (f32x4){0.f, 0.f, 0.f, 0.f};
        cur = nxt; cA = nA; cB = nB; ++ui;
        if constexpr (ALIGN_EPI) { if (wr == 1) PG8_BAR; }
    }
    PG8_WAIT_V(0);
    if constexpr (!ALIGN_EPI) { if (wr == 0) PG8_BAR; }
    PG8_BAR;
    if constexpr (Epi::AFTER_DRAIN) { E.fused(acc, cur, wr, wc, fr, fq, lds, wid, lane); S.done(cur); }
#undef PG8_SA
#undef PG8_SB
#undef PG8_STAGE
#undef PG8_LDA
#undef PG8_LDB
#undef PG8_MMA
#undef PG8_WAIT_V
#undef PG8_WAIT_L
#undef PG8_BAR
#undef PG8_SCHED
}
}

namespace fa {
typedef short bf16x8 __attribute__((ext_vector_type(8)));
typedef float f32x16 __attribute__((ext_vector_type(16)));
constexpr int KROW = 272, VROW = 144, KT_BYTES = 64 * KROW, VT_BYTES = 128 * VROW, STAGE = KT_BYTES + VT_BYTES;
static_assert(2 * STAGE <= PHASE_LDS && 4 * 128 * 32 * 4 <= 2 * STAGE, "attention LDS map");
__device__ __forceinline__ unsigned cvt_pk(float lo, float hi) { unsigned r; asm volatile("v_cvt_pk_bf16_f32 %0, %1, %2" : "=v"(r) : "v"(lo), "v"(hi)); return r; }
__device__ __forceinline__ bf16x8 pack8(const f32x16& p, int b) {
    u32x4 w; w.x = cvt_pk(p[b + 0], p[b + 1]); w.y = cvt_pk(p[b + 2], p[b + 3]); w.z = cvt_pk(p[b + 4], p[b + 5]); w.w = cvt_pk(p[b + 6], p[b + 7]);
    return __builtin_bit_cast(bf16x8, w);
}
__device__ __forceinline__ void attn_unit(LAS unsigned char* lds, const bf16* Qg, const bf16* Kg, const bf16* Vg, const int Lk, bf16* MIXg, const float* subg, const float lam, const float post) {
    const int tid = threadIdx.x, lane = tid & 63, wid = __builtin_amdgcn_readfirstlane(tid >> 6), sm = wid & 1, qblk = wid >> 1, l31 = lane & 31, hh = lane >> 5;
    bf16x8 qf[4];
    { const bf16* qrow = Qg + (size_t)(qblk * 32 + l31) * 512 + sm * 64 + hh * 8;
#pragma unroll
      for (int ks = 0; ks < 4; ++ks) qf[ks] = *(const bf16x8*)(qrow + 16 * ks); }
    f32x16 o[4];
#pragma unroll
    for (int db = 0; db < 4; ++db)
#pragma unroll
        for (int r = 0; r < 16; ++r) o[db][r] = 0.f;
    float m_run = -1e30f, l_run = 0.f;
    const int nt = Lk >> 6;
    const int kr = tid >> 3, kc = tid & 7, vr = tid >> 2, vc = tid & 3;
    const bf16* kg = Kg + (size_t)kr * 512 + kc * 8;
    const bf16* vg = Vg + (size_t)vr * Lk + vc * 8;
    const int kw = kr * KROW + kc * 16, vw = KT_BYTES + vr * VROW + vc * 16;
    u32x4 sk0 = *(const u32x4*)(kg), sk1 = *(const u32x4*)(kg + 64), sv0 = *(const u32x4*)(vg), sv1 = *(const u32x4*)(vg + 32);
    *(LAS u32x4*)(lds + kw) = sk0; *(LAS u32x4*)(lds + kw + 128) = sk1; *(LAS u32x4*)(lds + vw) = sv0; *(LAS u32x4*)(lds + vw + 64) = sv1;
    __syncthreads();
    const int ka = l31 * KROW + (sm * 64 + hh * 8) * 2, va = KT_BYTES + l31 * VROW + hh * 16;
#pragma unroll 1
    for (int i = 0; i < nt; ++i) {
        LAS unsigned char* cur = lds + (i & 1) * STAGE;
        const bool more = (i + 1 < nt);
        if (more) { const bf16* k2 = kg + (size_t)(i + 1) * 64 * 512; const bf16* v2 = vg + (i + 1) * 64;
            sk0 = *(const u32x4*)(k2); sk1 = *(const u32x4*)(k2 + 64); sv0 = *(const u32x4*)(v2); sv1 = *(const u32x4*)(v2 + 32); }
        f32x16 s0, s1;
#pragma unroll
        for (int r = 0; r < 16; ++r) { s0[r] = 0.f; s1[r] = 0.f; }
#pragma unroll
        for (int ks = 0; ks < 4; ++ks) {
            const bf16x8 a0 = *(const LAS bf16x8*)(cur + ka + ks * 32), a1 = *(const LAS bf16x8*)(cur + ka + 32 * KROW + ks * 32);
            s0 = __builtin_amdgcn_mfma_f32_32x32x16_bf16(a0, qf[ks], s0, 0, 0, 0);
            s1 = __builtin_amdgcn_mfma_f32_32x32x16_bf16(a1, qf[ks], s1, 0, 0, 0);
        }
        float mx = fmaxf(s0[0], s1[0]);
#pragma unroll
        for (int r = 1; r < 16; ++r) mx = fmaxf(mx, fmaxf(s0[r], s1[r]));
        mx = fmaxf(mx, __shfl_xor(mx, 32));
        if (__any(mx > m_run)) {
            const float mn = fmaxf(m_run, mx), alpha = __builtin_amdgcn_exp2f(m_run - mn);
#pragma unroll
            for (int db = 0; db < 4; ++db)
#pragma unroll
                for (int r = 0; r < 16; ++r) o[db][r] *= alpha;
            l_run *= alpha; m_run = mn;
        }
        float ps = 0.f;
#pragma unroll
        for (int r = 0; r < 16; ++r) { s0[r] = __builtin_amdgcn_exp2f(s0[r] - m_run); s1[r] = __builtin_amdgcn_exp2f(s1[r] - m_run); ps += s0[r] + s1[r]; }
        l_run += ps;
        bf16x8 pf[4];
        pf[0] = pack8(s0, 0); pf[1] = pack8(s0, 8); pf[2] = pack8(s1, 0); pf[3] = pack8(s1, 8);
#pragma unroll
        for (int db = 0; db < 4; ++db)
#pragma unroll
            for (int st = 0; st < 4; ++st) {
                const bf16x8 a = *(const LAS bf16x8*)(cur + va + db * 32 * VROW + st * 32);
                o[db] = __builtin_amdgcn_mfma_f32_32x32x16_bf16(a, pf[st], o[db], 0, 0, 0);
            }
        if (more) { LAS unsigned char* nx = lds + ((i + 1) & 1) * STAGE;
            *(LAS u32x4*)(nx + kw) = sk0; *(LAS u32x4*)(nx + kw + 128) = sk1; *(LAS u32x4*)(nx + vw) = sv0; *(LAS u32x4*)(nx + vw + 64) = sv1; }
        __syncthreads();
    }
    const float ltot = l_run + __shfl_xor(l_run, 32);
    LAS float* X = (LAS float*)lds + qblk * 128 * 32;
    if (sm == 1) {
        const float sc = lam / ltot;
#pragma unroll
        for (int db = 0; db < 4; ++db)
#pragma unroll
            for (int r = 0; r < 16; ++r) X[(32 * db + (r & 3) + 8 * (r >> 2) + 4 * hh) * 32 + l31] = o[db][r] * sc;
    }
    __syncthreads();
    if (sm == 0) {
        const float sc = 1.0f / ltot; float ss = 0.f;
#pragma unroll
        for (int db = 0; db < 4; ++db)
#pragma unroll
            for (int r = 0; r < 16; ++r) { const float v = o[db][r] * sc - X[(32 * db + (r & 3) + 8 * (r >> 2) + 4 * hh) * 32 + l31]; o[db][r] = v; ss += v * v; }
        ss += __shfl_xor(ss, 32);
        const float rs = post / sqrtf(ss * (1.0f / 128.0f) + EPS);
        bf16* orow = MIXg + (size_t)(qblk * 32 + l31) * D + 4 * hh;
#pragma unroll
        for (int db = 0; db < 4; ++db)
#pragma unroll
            for (int g4 = 0; g4 < 4; ++g4) {
                const int d = 32 * db + 8 * g4;
                const f32x4 gv = *(const f32x4*)(subg + d + 4 * hh);
                const unsigned w0 = cvt_pk(o[db][4 * g4 + 0] * rs * gv.x, o[db][4 * g4 + 1] * rs * gv.y), w1 = cvt_pk(o[db][4 * g4 + 2] * rs * gv.z, o[db][4 * g4 + 3] * rs * gv.w);
                *(u32x2*)(orow + d) = (u32x2){w0, w1};
            }
    }
    __syncthreads();
}
}
namespace mx {
typedef short bf16x8 __attribute__((ext_vector_type(8)));
typedef float f32x16 __attribute__((ext_vector_type(16)));
__device__ __forceinline__ unsigned cvt_pk(float lo, float hi) { unsigned r; asm volatile("v_cvt_pk_bf16_f32 %0, %1, %2" : "=v"(r) : "v"(lo), "v"(hi)); return r; }
__device__ __forceinline__ bf16x8 pack8f(const f32x4 a, const f32x4 b) { u32x4 w; w.x = cvt_pk(a.x, a.y); w.y = cvt_pk(a.z, a.w); w.z = cvt_pk(b.x, b.y); w.w = cvt_pk(b.z, b.w); return __builtin_bit_cast(bf16x8, w); }
constexpr int VROW = 272;
__device__ __forceinline__ void sgu_unit(const Args& a, Frame& F, const int chunk, const float* gn, const float* wsg, const float* bsg) {
    LAS unsigned char* vt = F.lds;
    const bf16* VG = (const bf16*)(a.ws + WS_VG); const bf16* U = (const bf16*)(a.ws + WS_U); bf16* MIX = (bf16*)(a.ws + WS_MIX);
    const int m0 = chunk * 128, lane = F.lane, l31 = lane & 31, hh = lane >> 5;
    {
        const int q = F.tid >> 2, j = F.tid & 3;
        const u32x4* src = (const u32x4*)(VG + (size_t)(m0 + q) * 256 + 64 * j);
        u32x4 w[8];
#pragma unroll
        for (int i = 0; i < 8; ++i) w[i] = src[i];
        float x[64]; float s1 = 0.f, s2 = 0.f;
#pragma unroll
        for (int i = 0; i < 8; ++i) {
            x[8 * i + 0] = bflo(w[i].x); x[8 * i + 1] = bfhi(w[i].x); x[8 * i + 2] = bflo(w[i].y); x[8 * i + 3] = bfhi(w[i].y);
            x[8 * i + 4] = bflo(w[i].z); x[8 * i + 5] = bfhi(w[i].z); x[8 * i + 6] = bflo(w[i].w); x[8 * i + 7] = bfhi(w[i].w);
        }
#pragma unroll
        for (int i = 0; i < 64; ++i) { s1 += x[i]; s2 += x[i] * x[i]; }
        s1 += __shfl_xor(s1, 1); s2 += __shfl_xor(s2, 1); s1 += __shfl_xor(s1, 2); s2 += __shfl_xor(s2, 2);
        const float mean = s1 * (1.0f / 256.0f);
        const float var = fmaxf(s2 * (1.0f / 256.0f) - mean * mean, 0.f);
        const float r = 1.0f / sqrtf(var + EPS);
        const float* gp = gn + 64 * j;
        LAS bf16* dst = (LAS bf16*)(vt + (64 * j) * VROW) + q;
#pragma unroll
        for (int i = 0; i < 16; ++i) {
            const f32x4 g4 = *(const f32x4*)(gp + 4 * i);
            dst[(4 * i + 0) * (VROW / 2)] = (bf16)f2bf((x[4 * i + 0] - mean) * r * g4.x);
            dst[(4 * i + 1) * (VROW / 2)] = (bf16)f2bf((x[4 * i + 1] - mean) * r * g4.y);
            dst[(4 * i + 2) * (VROW / 2)] = (bf16)f2bf((x[4 * i + 2] - mean) * r * g4.z);
            dst[(4 * i + 3) * (VROW / 2)] = (bf16)f2bf((x[4 * i + 3] - mean) * r * g4.w);
        }
    }
    __syncthreads();
    const int g = F.wave >> 1, cb = F.wave & 1;
    f32x16 acc[4];
#pragma unroll
    for (int pb = 0; pb < 4; ++pb)
#pragma unroll
        for (int r = 0; r < 16; ++r) acc[pb][r] = 0.f;
    const LAS unsigned char* arow = vt + (64 * g + 32 * cb + l31) * VROW + 16 * hh;
    const float* wrow = wsg + ((size_t)g * 128 + l31) * 128 + 8 * hh;
#pragma unroll
    for (int ks = 0; ks < 8; ++ks) {
        const bf16x8 A = *(const LAS bf16x8*)(arow + 32 * ks);
#pragma unroll
        for (int pb = 0; pb < 4; ++pb) {
            const float* wq = wrow + (size_t)pb * 32 * 128 + 16 * ks;
            const bf16x8 B = pack8f(*(const f32x4*)(wq), *(const f32x4*)(wq + 4));
            acc[pb] = __builtin_amdgcn_mfma_f32_32x32x16_bf16(A, B, acc[pb], 0, 0, 0);
        }
    }
#pragma unroll
    for (int pb = 0; pb < 4; ++pb) {
        const int p = 32 * pb + l31;
        const float bias = bsg[g * 128 + p];
        const bf16* urow = U + (size_t)(m0 + p) * 256 + 64 * g + 32 * cb + 4 * hh;
        bf16* orow = MIX + (size_t)(m0 + p) * D + 768 + 64 * g + 32 * cb + 4 * hh;
#pragma unroll
        for (int q4 = 0; q4 < 4; ++q4) {
            const u32x2 uw = *(const u32x2*)(urow + 8 * q4);
            const unsigned w0 = cvt_pk(bflo(uw.x) * (acc[pb][4 * q4 + 0] + bias), bfhi(uw.x) * (acc[pb][4 * q4 + 1] + bias));
            const unsigned w1 = cvt_pk(bflo(uw.y) * (acc[pb][4 * q4 + 2] + bias), bfhi(uw.y) * (acc[pb][4 * q4 + 3] + bias));
            *(u32x2*)(orow + 8 * q4) = (u32x2){w0, w1};
        }
    }
    __syncthreads();
}
constexpr int QROW = 528;
__device__ __forceinline__ void pool_unit(const Args& a, Frame& F, const int unit, const bf16x8 (&bw)[4], const float ps) {
    LAS float* P = (LAS float*)F.lds;
    LAS unsigned char* Qb = F.lds + 48 * 256 * 4;
    const bf16* PP = (const bf16*)(a.ws + WS_PP); bf16* MIX = (bf16*)(a.ws + WS_MIX);
    const int m0 = unit * 32;
    const bool smp = m0 >= MP;
    const int L = smp ? LS : LP;
    const int t0 = smp ? ((m0 - MP) & 1023) : (m0 & 255);
    const int mseq = m0 - t0;
    {
        u32x4 w[3];
#pragma unroll
        for (int k = 0; k < 3; ++k) { const int ch = F.tid + 512 * k, r = ch >> 5, c8 = (ch & 31) * 8, t = t0 - 8 + r;
            w[k] = (u32x4){0u, 0u, 0u, 0u};
            if (t >= 0 && t < L) w[k] = *(const u32x4*)(PP + (size_t)(mseq + t) * 256 + c8); }
#pragma unroll
        for (int k = 0; k < 3; ++k) { const int ch = F.tid + 512 * k, r = ch >> 5, c8 = (ch & 31) * 8;
            *(LAS f32x4*)(P + r * 256 + c8) = (f32x4){bflo(w[k].x), bfhi(w[k].x), bflo(w[k].y), bfhi(w[k].y)};
            *(LAS f32x4*)(P + r * 256 + c8 + 4) = (f32x4){bflo(w[k].z), bfhi(w[k].z), bflo(w[k].w), bfhi(w[k].w)}; }
    }
    __syncthreads();
    {
        const int c = F.tid & 255, half = F.tid >> 8, hw = 1 << (c >> 6);
        const LAS float* Pc = P + c;
        const int r0 = 16 * half + 8;
        float sacc = 0.f;
#pragma unroll
        for (int u = -8; u < 8; ++u) { const float v = Pc[(r0 + u) * 256]; sacc += (u >= -hw && u < hw) ? v : 0.f; }
#pragma unroll
        for (int k = 0; k < 16; ++k) {
            const int tt = 16 * half + k, t = t0 + tt;
            const int lo = (t - hw < 0) ? 0 : t - hw, hi = (t + hw > L) ? L : t + hw;
            const float ctr = Pc[(tt + 8) * 256];
            *((LAS bf16*)(Qb + tt * QROW) + c) = (bf16)f2bf(sacc * __builtin_amdgcn_rcpf((float)(hi - lo)) - ctr);
            sacc += Pc[(tt + 8 + hw) * 256] - Pc[(tt + 8 - hw) * 256];
        }
    }
    __syncthreads();
    const int g = F.wave >> 1, dblk = F.wave & 1, l31 = F.lane & 31, hh = F.lane >> 5;
    f32x16 acc;
#pragma unroll
    for (int r = 0; r < 16; ++r) acc[r] = 0.f;
#pragma unroll
    for (int ks = 0; ks < 4; ++ks) {
        const bf16x8 A = *(const LAS bf16x8*)(Qb + l31 * QROW + (64 * g + 16 * ks + 8 * hh) * 2);
        acc = __builtin_amdgcn_mfma_f32_32x32x16_bf16(A, bw[ks], acc, 0, 0, 0);
    }
    bf16* o = MIX + (size_t)m0 * D + 64 * g + 32 * dblk + l31;
#pragma unroll
    for (int r = 0; r < 16; ++r) o[(size_t)((r & 3) + 8 * (r >> 2) + 4 * hh) * D] = (bf16)f2bf(acc[r] * ps);
    __syncthreads();
}
}
__device__ __forceinline__ void mixer_phase(const Args& a, Frame& F, int l) {
    const int G = gridDim.x, c = blockIdx.x;
    const int v = (G % 8 == 0) ? (c % 8) * (G / 8) + c / 8 : c;
    const float lam = ((const float*)(a.ws + WS_LAM))[l];
    const float post = 1.0f - ((l == 0) ? 0.2f : (float)(0.8 - 0.6 * 0.7408182206817179));
    const float* subg = inp(F, 16) + l * 128;
    const bf16* Q = (const bf16*)(a.ws + WS_Q); bf16* MIX = (bf16*)(a.ws + WS_MIX);
#pragma unroll 1
    for (int rep = 0; rep < REP_ATTN_BIG; ++rep)
#pragma unroll 1
    for (int u = v; u < 256; u += G) {
        const int bh = u >> 3, qb = u & 7, b = bh >> 2, h = bh & 3, m0 = MP + b * LS + qb * 128;
        fa::attn_unit(F.lds, Q + (size_t)m0 * 512 + h * 128, (const bf16*)(a.ws + WS_KS) + (size_t)b * LKS * 512 + h * 128, (const bf16*)(a.ws + WS_VTS) + (size_t)(b * 4 + h) * 128 * LKS, LKS,
                      MIX + (size_t)m0 * D + 256 + h * 128, subg, lam, post);
    }
    const bool g256 = (G == 256);
    int a_lo = v, a_hi = 128, a_st = G, s_lo = v, s_hi = 96, s_st = G, p_lo = v, p_hi = 384, p_st = G;
    if (g256) {
        if (v < 128) { a_lo = v; a_hi = v + 1; s_lo = 0; s_hi = 0; p_lo = v; p_hi = v + 1; }
        else if (v < 224) { a_lo = 0; a_hi = 0; s_lo = v - 128; s_hi = s_lo + 1; p_lo = 128 + 2 * (v - 128); p_hi = p_lo + 2; }
        else { a_lo = 0; a_hi = 0; s_lo = 0; s_hi = 0; p_lo = 320 + 2 * (v - 224); p_hi = p_lo + 2; }
        a_st = 1; s_st = 1; p_st = 1;
    }
#pragma unroll 1
    for (int u = a_lo; u < a_hi; u += a_st) {
        const int bh = u >> 1, qb = u & 1, b = bh >> 2, h = bh & 3, m0 = b * LP + qb * 128;
        fa::attn_unit(F.lds, Q + (size_t)m0 * 512 + h * 128, (const bf16*)(a.ws + WS_KP) + (size_t)b * LP * 512 + h * 128, (const bf16*)(a.ws + WS_VTP) + (size_t)(b * 4 + h) * 128 * LP, LP,
                      MIX + (size_t)m0 * D + 256 + h * 128, subg, lam, post);
    }
    {
        const float* gn = inp(F, 17) + l * 256; const float* wsg = inp(F, 18) + (size_t)l * 4 * 128 * 128; const float* bsg = inp(F, 19) + l * 4 * 128;
#pragma unroll 1
        for (int u = s_lo; u < s_hi; u += s_st) mx::sgu_unit(a, F, u, gn, wsg, bsg);
    }
    if (p_lo < p_hi) {
        const int g = F.wave >> 1, dblk = F.wave & 1, l31 = F.lane & 31, hh = F.lane >> 5;
        const float* wp = inp(F, 10) + (size_t)l * 4 * 64 * 64 + (size_t)g * 4096 + 32 * dblk + l31;
        mx::bf16x8 bw[4];
#pragma unroll
        for (int ks = 0; ks < 4; ++ks) {
            const float* q = wp + (size_t)(16 * ks + 8 * hh) * 64;
            bw[ks] = mx::pack8f((f32x4){q[0], q[64], q[128], q[192]}, (f32x4){q[256], q[320], q[384], q[448]});
        }
        const float ps = (inp(F, 11) + l * 256)[64 * g + 32 * dblk + l31];
#pragma unroll 1
        for (int u = p_lo; u < p_hi; u += p_st) mx::pool_unit(a, F, u, bw, ps);
    }
}

__device__ __forceinline__ void attn_ref(const Args& a, Frame& F, int l) {
    LAS float* wq = (LAS float*)F.lds + F.wave * (128 + 3 * LKS);
    LAS float* ws1 = wq + 128;
    LAS float* ws2 = ws1 + LKS;
    LAS float* wp = ws2 + LKS;
    const bf16* Q = (const bf16*)(a.ws + WS_Q);
    bf16* MIX = (bf16*)(a.ws + WS_MIX);
    const float lam = ((const float*)(a.ws + WS_LAM))[l];
    const float lam_init = (l == 0) ? 0.2f : (float)(0.8 - 0.6 * 0.7408182206817179);
    const float* subg = inp(F, 16) + l * 128;
    const int gw = blockIdx.x * NWAVES + F.wave, NGW = gridDim.x * NWAVES;
#pragma unroll 1
    for (int it = gw; it < M * 4; it += NGW) {
        const int m = it >> 2, h = it & 3;
        const bool smp = m >= MP;
        const int b = smp ? ((m - MP) >> 10) : (m >> 8);
        const int Lk = smp ? LKS : LP, nk = Lk >> 6;
        const bf16* Kb = smp ? (const bf16*)(a.ws + WS_KS) + (size_t)b * LKS * 512 + h * 128 : (const bf16*)(a.ws + WS_KP) + (size_t)b * LP * 512 + h * 128;
        const bf16* Vb = smp ? (const bf16*)(a.ws + WS_VTS) + (size_t)(b * 4 + h) * 128 * LKS : (const bf16*)(a.ws + WS_VTP) + (size_t)(b * 4 + h) * 128 * LP;
        wq[F.lane] = bf2f(Q[(size_t)m * 512 + h * 128 + F.lane]); wq[64 + F.lane] = bf2f(Q[(size_t)m * 512 + h * 128 + 64 + F.lane]);
        asm volatile("s_waitcnt lgkmcnt(0)" ::: "memory");
        float m1 = -1e30f, m2 = -1e30f;
#pragma unroll 1
        for (int kk = 0; kk < nk; ++kk) {
            const u32x4* kr = (const u32x4*)(Kb + (size_t)(kk * 64 + F.lane) * 512);
            float d1 = 0.f, d2 = 0.f;
#pragma unroll
            for (int c = 0; c < 8; ++c) {
                const u32x4 k1 = kr[c], k2 = kr[8 + c];
                const f32x4 qa = *(const LAS f32x4*)(wq + 8 * c), qb = *(const LAS f32x4*)(wq + 8 * c + 4);
                const f32x4 qc = *(const LAS f32x4*)(wq + 64 + 8 * c), qd = *(const LAS f32x4*)(wq + 64 + 8 * c + 4);
                d1 += qa.x * bflo(k1.x) + qa.y * bfhi(k1.x) + qa.z * bflo(k1.y) + qa.w * bfhi(k1.y) + qb.x * bflo(k1.z) + qb.y * bfhi(k1.z) + qb.z * bflo(k1.w) + qb.w * bfhi(k1.w);
                d2 += qc.x * bflo(k2.x) + qc.y * bfhi(k2.x) + qc.z * bflo(k2.y) + qc.w * bfhi(k2.y) + qd.x * bflo(k2.z) + qd.y * bfhi(k2.z) + qd.z * bflo(k2.w) + qd.w * bfhi(k2.w);
            }
            ws1[kk * 64 + F.lane] = d1; ws2[kk * 64 + F.lane] = d2;
            m1 = fmaxf(m1, d1); m2 = fmaxf(m2, d2);
        }
        m1 = wave_max(m1); m2 = wave_max(m2);
        asm volatile("s_waitcnt lgkmcnt(0)" ::: "memory");
        float l1 = 0.f, l2 = 0.f;
#pragma unroll 1
        for (int kk = 0; kk < nk; ++kk) {
            const float e1 = exp2f(ws1[kk * 64 + F.lane] - m1), e2 = exp2f(ws2[kk * 64 + F.lane] - m2);
            ws1[kk * 64 + F.lane] = e1; ws2[kk * 64 + F.lane] = e2; l1 += e1; l2 += e2;
        }
        l1 = wave_sum(l1); l2 = wave_sum(l2);
        const float i1 = 1.0f / l1, i2 = lam / l2;
        asm volatile("s_waitcnt lgkmcnt(0)" ::: "memory");
#pragma unroll 1
        for (int kk = 0; kk < nk; ++kk) wp[perm16(kk * 64 + F.lane)] = ws1[kk * 64 + F.lane] * i1 - ws2[kk * 64 + F.lane] * i2;
        asm volatile("s_waitcnt lgkmcnt(0)" ::: "memory");
        float o0 = 0.f, o1 = 0.f;
        const bf16* v0 = Vb + (size_t)F.lane * Lk; const bf16* v1 = Vb + (size_t)(64 + F.lane) * Lk;
#pragma unroll 2
        for (int p = 0; p < Lk; p += 8) {
            const u32x4 a0 = *(const u32x4*)(v0 + p), a1 = *(const u32x4*)(v1 + p);
            const f32x4 pa = *(const LAS f32x4*)(wp + p), pb = *(const LAS f32x4*)(wp + p + 4);
            o0 += pa.x * bflo(a0.x) + pa.y * bfhi(a0.x) + pa.z * bflo(a0.y) + pa.w * bfhi(a0.y) + pb.x * bflo(a0.z) + pb.y * bfhi(a0.z) + pb.z * bflo(a0.w) + pb.w * bfhi(a0.w);
            o1 += pa.x * bflo(a1.x) + pa.y * bfhi(a1.x) + pa.z * bflo(a1.y) + pa.w * bfhi(a1.y) + pb.x * bflo(a1.z) + pb.y * bfhi(a1.z) + pb.z * bflo(a1.w) + pb.w * bfhi(a1.w);
        }
        const float ss = wave_sum(o0 * o0 + o1 * o1);
        const float r = (1.0f / sqrtf(ss * (1.0f / 128.0f) + EPS)) * (1.0f - lam_init);
        MIX[(size_t)m * D + 256 + h * 128 + F.lane] = (bf16)f2bf(o0 * r * subg[F.lane]);
        MIX[(size_t)m * D + 256 + h * 128 + 64 + F.lane] = (bf16)f2bf(o1 * r * subg[64 + F.lane]);
        asm volatile("s_waitcnt lgkmcnt(0)" ::: "memory");
    }
}
__device__ __forceinline__ void pool_phase(const Args& a, Frame& F, int l) {
    LAS float* P = (LAS float*)F.lds;
    LAS float* Qp = P + 48 * 256;
    LAS float* Wl = Qp + 32 * 256;
    const bf16* PP = (const bf16*)(a.ws + WS_PP);
    bf16* MIX = (bf16*)(a.ws + WS_MIX);
    const float* wpool = inp(F, 10) + (size_t)l * 4 * 64 * 64; const float* pscale = inp(F, 11) + l * 256;
    bool have = false;
#pragma unroll 1
    for (int unit = blockIdx.x; unit < M / 32; unit += gridDim.x) {
        const int m0 = unit * 32;
        const bool smp = m0 >= MP;
        const int L = smp ? LS : LP;
        const int t0 = smp ? ((m0 - MP) & 1023) : (m0 & 255);
        const int mseq = m0 - t0;
        __syncthreads();
        if (!have) { for (int i = F.tid; i < 4 * 64 * 64 / 4; i += NTHREADS) *(LAS f32x4*)(Wl + 4 * i) = *(const f32x4*)(wpool + 4 * i); have = true; }
#pragma unroll 1
        for (int i = F.tid; i < 48 * 64; i += NTHREADS) {
            const int r = i >> 6, c4 = (i & 63) * 4, t = t0 - 8 + r;
            f32x4 v = {0.f, 0.f, 0.f, 0.f};
            if (t >= 0 && t < L) { const u32x2 w = *(const u32x2*)(PP + (size_t)(mseq + t) * 256 + c4); v = (f32x4){bflo(w.x), bfhi(w.x), bflo(w.y), bfhi(w.y)}; }
            *(LAS f32x4*)(P + r * 256 + c4) = v;
        }
        __syncthreads();
#pragma unroll 1
        for (int i = F.tid; i < 32 * 256; i += NTHREADS) {
            const int tt = i >> 8, c = i & 255, g = c >> 6, hw = 1 << g;
            const int t = t0 + tt;
            int lo = t - hw; if (lo < 0) lo = 0;
            int hi = t + hw; if (hi > L) hi = L;
            float s = 0.f;
#pragma unroll 1
            for (int u = lo; u < hi; ++u) s += P[(u - t0 + 8) * 256 + c];
            Qp[tt * 256 + c] = s / (float)(hi - lo) - P[(tt + 8) * 256 + c];
        }
        __syncthreads();
        {
            const int d = F.tid & 63, g = (F.tid >> 6) & 3, half = F.tid >> 8;
            const float ps = pscale[g * 64 + d];
            const LAS float* wg = Wl + g * 4096 + d;
#pragma unroll 1
            for (int tt = half * 16; tt < half * 16 + 16; ++tt) {
                float acc = 0.f;
#pragma unroll 4
                for (int c = 0; c < 64; c += 4) { const f32x4 q = *(const LAS f32x4*)(Qp + tt * 256 + g * 64 + c);
                    acc += q.x * wg[(c + 0) * 64] + q.y * wg[(c + 1) * 64] + q.z * wg[(c + 2) * 64] + q.w * wg[(c + 3) * 64]; }
                MIX[(size_t)(m0 + tt) * D + g * 64 + d] = (bf16)f2bf(acc * ps);
            }
        }
    }
    __syncthreads();
}
__device__ __forceinline__ void sgu_ref(const Args& a, Frame& F, int l) {
    LAS float* vn = (LAS float*)F.lds;
    const bf16* VG = (const bf16*)(a.ws + WS_VG); const bf16* U = (const bf16*)(a.ws + WS_U);
    bf16* MIX = (bf16*)(a.ws + WS_MIX);
    const float* gn = inp(F, 17) + l * 256; const float* wsg = inp(F, 18) + (size_t)l * 4 * 128 * 128; const float* bsg = inp(F, 19) + l * 4 * 128;
    for (int unit = blockIdx.x; unit < M / 128; unit += gridDim.x) {
        const int m0 = unit * 128;
        __syncthreads();
        for (int q = F.wave; q < 128; q += NWAVES) {
            const u32x2 w = *(const u32x2*)(VG + (size_t)(m0 + q) * 256 + 4 * F.lane);
            const float x0 = bflo(w.x), x1 = bfhi(w.x), x2 = bflo(w.y), x3 = bfhi(w.y);
            const float mean = wave_sum((x0 + x1) + (x2 + x3)) * (1.0f / 256.0f);
            const float d0 = x0 - mean, d1 = x1 - mean, d2 = x2 - mean, d3 = x3 - mean;
            const float var = wave_sum((d0 * d0 + d1 * d1) + (d2 * d2 + d3 * d3)) * (1.0f / 256.0f);
            const float r = 1.0f / sqrtf(var + EPS);
            const f32x4 g4 = *(const f32x4*)(gn + 4 * F.lane);
            *(LAS f32x4*)(vn + q * 256 + 4 * F.lane) = (f32x4){d0 * r * g4.x, d1 * r * g4.y, d2 * r * g4.z, d3 * r * g4.w};
        }
        __syncthreads();
        const int c = F.tid & 255, ph = F.tid >> 8, g = c >> 6;
        for (int p = ph * 64; p < ph * 64 + 64; ++p) {
            const float* wr = wsg + ((size_t)g * 128 + p) * 128;
            float acc = bsg[g * 128 + p];
#pragma unroll 8
            for (int q = 0; q < 128; ++q) acc += wr[q] * vn[q * 256 + c];
            const float u = bf2f(U[(size_t)(m0 + p) * 256 + c]);
            MIX[(size_t)(m0 + p) * D + 768 + c] = (bf16)f2bf(u * acc);
        }
    }
    __syncthreads();
}
__device__ __forceinline__ void final_phase(const Args& a, Frame& F) {
    const float* g = inp(F, 24);
    const int gw = blockIdx.x * NWAVES + F.wave, NGW = gridDim.x * NWAVES;
    for (int m = gw; m < M; m += NGW) {
        f32x4* xr = (f32x4*)(a.out + (size_t)m * D) + F.lane;
        f32x4 v[4]; float s = 0.f;
#pragma unroll
        for (int j = 0; j < 4; ++j) { v[j] = xr[64 * j]; s += (v[j].x * v[j].x + v[j].y * v[j].y) + (v[j].z * v[j].z + v[j].w * v[j].w); }
        const float rstd = 1.0f / sqrtf(wave_sum(s) * (1.0f / D) + EPS);
#pragma unroll
        for (int j = 0; j < 4; ++j) { const f32x4 gv = *(const f32x4*)(g + 4 * (64 * j + F.lane)); xr[64 * j] = (f32x4){v[j].x * rstd * gv.x, v[j].y * rstd * gv.y, v[j].z * rstd * gv.z, v[j].w * rstd * gv.w}; }
    }
}

#define XB_TMO      128
#define XB_XCNT(j)  (256  + 64 * (j))
#define XB_XSUB(j)  (1280 + 64 * (j))
#define XB_XGEN(j)  (2304 + 64 * (j))
#define XB_TOP      3328
#define XB_TOPGEN   3392
#define XCD_BAR_WORDS 3456
#define XB_SPIN_CAP (1u << 20)
__device__ __forceinline__ unsigned xb_ld(unsigned* p)              { return __hip_atomic_load(p, __ATOMIC_RELAXED, __HIP_MEMORY_SCOPE_AGENT); }
__device__ __forceinline__ unsigned xb_add(unsigned* p, unsigned v) { return __hip_atomic_fetch_add(p, v, __ATOMIC_RELAXED, __HIP_MEMORY_SCOPE_AGENT); }
__device__ __forceinline__ unsigned xb_xcc_id() { return (unsigned)__builtin_amdgcn_s_getreg((3 << 11) | 20) & 0xFu; }
#define XB_SPIN(cond, bar) do { unsigned _sp = 0; while (cond) { __builtin_amdgcn_s_sleep(1); \
    if ((++_sp & 255u) == 0u) { if (xb_ld(&(bar)[XB_TMO])) break; if (_sp > XB_SPIN_CAP) { atomicAdd(&(bar)[XB_TMO], 1u); break; } } } } while (0)
struct XcdBarrier { unsigned* bar; unsigned x; volatile LAS unsigned* st; };
__device__ __forceinline__ XcdBarrier xcd_barrier_post(unsigned* bar, volatile LAS unsigned* st) {
    XcdBarrier b; b.bar = bar; b.x = xb_xcc_id(); b.st = st;
    if (threadIdx.x == 0) (void)xb_add(&bar[XB_XCNT(b.x)], 1u);
    return b;
}
__device__ __forceinline__ void xcd_barrier_complete(unsigned* bar, unsigned x, unsigned& nloc, unsigned& nx) {
    const unsigned G = gridDim.x * gridDim.y * gridDim.z;
    unsigned sum, cnt, mine, sp = 0u;
    for (;;) {
        sum = 0u; cnt = 0u; mine = 0u;
#pragma unroll
        for (unsigned j = 0; j < 16; ++j) { const unsigned c = xb_ld(&bar[XB_XCNT(j)]); sum += c; cnt += (c > 0u) ? 1u : 0u; mine = (j == x) ? c : mine; }
        if (sum == G) break;
        __builtin_amdgcn_s_sleep(1);
        if ((++sp & 255u) == 0u) { if (xb_ld(&bar[XB_TMO])) break; if (sp > XB_SPIN_CAP) { atomicAdd(&bar[XB_TMO], 1u); break; } }
    }
    nloc = mine > 0u ? mine : 1u; nx = cnt > 0u ? cnt : 1u;
}
__device__ __forceinline__ void xcd_barrier(const XcdBarrier& b) {
    asm volatile("s_waitcnt vmcnt(0)" ::: "memory");
    __syncthreads();
    if (threadIdx.x == 0) {
        unsigned* bar = b.bar;
        __builtin_amdgcn_s_waitcnt(0);
        unsigned nloc = b.st[0], nx = b.st[1];
        if (nloc == 0u) { xcd_barrier_complete(bar, b.x, nloc, nx); b.st[0] = nloc; b.st[1] = nx; }
        const unsigned old = xb_add(&bar[XB_XSUB(b.x)], 1u);
        const unsigned gen = old / nloc;
        if (old + 1u == (gen + 1u) * nloc) {
            __builtin_amdgcn_fence(__ATOMIC_RELEASE, "agent");
            asm volatile("s_waitcnt vmcnt(0)" ::: "memory");
            const unsigned og = xb_add(&bar[XB_TOP], 1u);
            const unsigned tg = og / nx;
            if (og + 1u == (tg + 1u) * nx) xb_add(&bar[XB_TOPGEN], 1u);
            else XB_SPIN(xb_ld(&bar[XB_TOPGEN]) == tg, bar);
            __builtin_amdgcn_fence(__ATOMIC_ACQUIRE, "agent");
            xb_add(&bar[XB_XGEN(b.x)], 1u);
            asm volatile("s_waitcnt vmcnt(0)" ::: "memory");
        } else {
            XB_SPIN(xb_ld(&bar[XB_XGEN(b.x)]) == gen, bar);
            __builtin_amdgcn_fence(__ATOMIC_ACQUIRE, "agent");
            asm volatile("s_waitcnt vmcnt(0)" ::: "memory");
        }
    }
    __syncthreads();
}

constexpr int NPHASES = 16;
#ifndef REF_MIX
#define REF_MIX 0
#endif
#ifndef REF_GEMM
#define REF_GEMM 0
#endif
#ifndef PHMASK
#define PHMASK 0xFFFF
#endif
#define PHM(k) ((PHMASK >> (k)) & 1)
template <int l>
__device__ __forceinline__ void layer_phases(const Args& args, Frame& F, const XcdBarrier& bar, const int lo, const int hi) {
    constexpr int pb = 1 + 7 * l;
#define IN(k) (lo <= (k) && (k) < hi)
#define SEAM(k) do { if (N_LAUNCHES == 1 && IN(k) && IN((k) + 1)) xcd_barrier(bar); } while (0)

        if (IN(pb + 0)) for (int rep = 0; rep < REP_NORM1; ++rep) { if (PHM(1)) { norm_phase(args, F, l, 0); cache_phase(args, F, l); } }
        SEAM(pb + 0);
        if (IN(pb + 1)) for (int rep = 0; rep < REP_INPROJ; ++rep) { if (PHM(2)) {
#if REF_GEMM
            RefEpiIn E{&args, l}; ref_gemm<16, RefEpiIn>(F.lds, (const bf16*)(args.ws + WS_H), (const bf16*)(args.ws + WS_WIN) + (size_t)l * NIN * D, M, NIN, D, E);
#else
            pg8::Gemm g{(const bf16*)(args.ws + WS_H), (const bf16*)(args.ws + WS_WIN) + (size_t)l * NIN * D, M, NIN, D}; pg8::StaticOrder S; S.init(M, NIN, (int)gridDim.x, (int)blockIdx.x);
            pg8::EpiIn E{args.ws, args.out, l}; pg8::gemm_phase<pg8::EpiIn, pg8::StaticOrder, true, true>(F.lds, g, S, E);
#endif
        } }
        SEAM(pb + 1);
        if (IN(pb + 2)) for (int rep = 0; rep < REP_MIX; ++rep) {
#if REF_MIX
            attn_ref(args, F, l); __syncthreads(); pool_phase(args, F, l); sgu_ref(args, F, l);
#else
            mixer_phase(args, F, l);
#endif
        }
        SEAM(pb + 2);
        if (IN(pb + 3)) { if (PHM(4)) {
#if REF_GEMM
            RefEpiRes E{&args, &F, l, 2, l == 0 ? 1 : 0}; ref_gemm<16, RefEpiRes>(F.lds, (const bf16*)(args.ws + WS_MIX), (const bf16*)(args.ws + WS_WOUT) + (size_t)l * D * D, M, D, D, E);
#else
            pg8::Gemm g{(const bf16*)(args.ws + WS_MIX), (const bf16*)(args.ws + WS_WOUT) + (size_t)l * D * D, M, D, D}; pg8::StaticOrder S; S.init(M, D, (int)gridDim.x, (int)blockIdx.x);
            pg8::EpiRes E{inp(F, 0), inp(F, 1), args.out, (const float*)(args.ws + WS_MOD) + (size_t)l * NCOND * NMOD + 2 * D, l == 0 ? 1 : 0};
            pg8::gemm_phase<pg8::EpiRes, pg8::StaticOrder, true, true>(F.lds, g, S, E);
#endif
        } }
        SEAM(pb + 3);
        if (IN(pb + 4)) for (int rep = 0; rep < REP_NORM2; ++rep) { if (PHM(5)) norm_phase(args, F, l, 1); }
        SEAM(pb + 4);
        if (IN(pb + 5)) for (int rep = 0; rep < REP_FFN1; ++rep) { if (PHM(6)) {
#if REF_GEMM
            RefEpiSwiglu E{&args}; ref_gemm<64, RefEpiSwiglu>(F.lds, (const bf16*)(args.ws + WS_H), (const bf16*)(args.ws + WS_WF1) + (size_t)l * 2 * DFF * D, M, 2 * DFF, D, E);
#else
            pg8::Gemm g{(const bf16*)(args.ws + WS_H), (const bf16*)(args.ws + WS_WF1) + (size_t)l * 2 * DFF * D, M, 2 * DFF, D}; pg8::StaticOrder S; S.init(M, 2 * DFF, (int)gridDim.x, (int)blockIdx.x);
            pg8::EpiSwiglu E{(bf16*)(args.ws + WS_ACT)}; pg8::gemm_phase<pg8::EpiSwiglu, pg8::StaticOrder, true, true>(F.lds, g, S, E);
#endif
        } }
        SEAM(pb + 5);
        if (IN(pb + 6)) { if (PHM(7)) {
#if REF_GEMM
            RefEpiRes E{&args, &F, l, 5, 0}; ref_gemm<16, RefEpiRes>(F.lds, (const bf16*)(args.ws + WS_ACT), (const bf16*)(args.ws + WS_WF2) + (size_t)l * D * DFF, M, D, DFF, E);
#else
            pg8::Gemm g{(const bf16*)(args.ws + WS_ACT), (const bf16*)(args.ws + WS_WF2) + (size_t)l * D * DFF, M, D, DFF}; pg8::StaticOrder S; S.init(M, D, (int)gridDim.x, (int)blockIdx.x);
            pg8::EpiRes E{inp(F, 0), inp(F, 1), args.out, (const float*)(args.ws + WS_MOD) + (size_t)l * NCOND * NMOD + 5 * D, 0};
            pg8::gemm_phase<pg8::EpiRes, pg8::StaticOrder, true, true>(F.lds, g, S, E);
#endif
        } }
        SEAM(pb + 6);

#undef IN
#undef SEAM
}

__global__ void __launch_bounds__(NTHREADS, 2) mk_fwd(Args args) {
    extern __shared__ __attribute__((aligned(16))) unsigned char lds_raw[];
    Frame F;
    F.lds = (LAS unsigned char*)lds_raw;
    F.tid = threadIdx.x; F.lane = F.tid & 63; F.wave = __builtin_amdgcn_readfirstlane(F.tid >> 6);
    const int lo = args.ph_lo, hi = args.ph_hi;
    for (int u = F.tid; u < 256; u += NTHREADS) ((LAS unsigned*)(F.lds + LDSCTL_OFF))[u] = 0u;
    __syncthreads();
    if (F.tid < 25) ((LAS unsigned long long*)(F.lds + LDSCTL_OFF + 64))[F.tid] = (unsigned long long)args.in[F.tid];
    __syncthreads();
    XcdBarrier bar; bar.bar = (unsigned*)(args.ws + WS_CTL) + CW_BAR; bar.x = 0; bar.st = (volatile LAS unsigned*)(F.lds + LDSCTL_OFF) + 8;
    if (N_LAUNCHES == 1) bar = xcd_barrier_post((unsigned*)(args.ws + WS_CTL) + CW_BAR, (volatile LAS unsigned*)(F.lds + LDSCTL_OFF) + 8);
#define IN(k) (lo <= (k) && (k) < hi)
#define SEAM(k) do { if (N_LAUNCHES == 1 && IN(k) && IN((k) + 1)) xcd_barrier(bar); } while (0)
    if (IN(0)) for (int rep = 0; rep < REP_P0; ++rep) { if (PHM(0)) { p0_ada(args, F); p0_weights(args, F); p0_misc(args, F); } }
    SEAM(0);
    layer_phases<0>(args, F, bar, lo, hi);
    layer_phases<1>(args, F, bar, lo, hi);
    if (IN(15)) { if (PHM(8)) final_phase(args, F); }
#undef IN
#undef SEAM
}

extern "C" void kernel_launch(void* const* d_in, const int* in_sizes, int n_in, void* d_out, int out_size, void* d_ws, size_t ws_size, hipStream_t stream) {
    static int grid = 0;
    if (grid == 0) {
        if (n_in != 25 || ws_size < WS_END) { fprintf(stderr, "kernel_launch: expected 25 inputs and >= %zu bytes of workspace; got %d, %zu\n", (size_t)WS_END, n_in, ws_size); grid = -1; return; }
        int dev = 0, cus = 0;
        if (hipGetDevice(&dev) != hipSuccess || hipDeviceGetAttribute(&cus, hipDeviceAttributeMultiprocessorCount, dev) != hipSuccess) { grid = -1; return; }
        if (hipFuncSetAttribute((const void*)mk_fwd, hipFuncAttributeMaxDynamicSharedMemorySize, LDS_BYTES) != hipSuccess) { fprintf(stderr, "kernel_launch: hipFuncSetAttribute failed\n"); grid = -1; return; }
        grid = cus;
    }
    if (grid < 0) return;
    Args a{};
    for (int i = 0; i < 25; ++i) a.in[i] = (const float*)d_in[i];
    a.out = (float*)d_out; a.ws = (unsigned char*)d_ws;
    if (hipMemsetAsync((char*)d_ws + WS_CTL, 0, CTL_ZERO_BYTES, stream) != hipSuccess) { fprintf(stderr, "kernel_launch: hipMemsetAsync failed\n"); return; }
    if (N_LAUNCHES == 1) {
        a.ph_lo = 0; a.ph_hi = NPHASES;
        hipLaunchKernelGGL(mk_fwd, dim3(grid), dim3(NTHREADS), LDS_BYTES, stream, a);
    } else {
        for (int ph = 0; ph < NPHASES; ++ph) {
            a.ph_lo = ph; a.ph_hi = ph + 1;
            hipLaunchKernelGGL(mk_fwd, dim3(grid), dim3(NTHREADS), LDS_BYTES, stream, a);
        }
    }
}
```
